# Optimizing an MI355X kernel written in HIP

```python
import jax, jax.numpy as jnp
from jax import lax
import numpy as np

D_MODEL = 4096
BATCH = 4
SEQ = 2048
DEPTH = 1

MEM_LEN = 256
EPS = 1e-6
ROPE_THETA = 500000.0
CHUNK = 128
A_GROUPS = 16
A_WIDTH = D_MODEL // 2
A_GROUP_DIM = A_WIDTH // A_GROUPS
B_HEADS = 16
B_HEAD_DIM = 128
B_KV_HEADS = 4
B_WIDTH = B_HEADS * B_HEAD_DIM
B_ROT = B_HEAD_DIM // 4
IDX_HEADS = 16
IDX_DIM = 64
IDX_ROT = IDX_DIM // 4
TOPK_MAX = 256
Q_BLOCK = 128
X_HEADS = 4
X_HEAD_DIM = 256
X_WIDTH = X_HEADS * X_HEAD_DIM
FFN_HIDDEN = -(-8 * D_MODEL // (3 * 256)) * 256
IN_SIZES = (2 * A_WIDTH, B_WIDTH, B_KV_HEADS * B_HEAD_DIM, B_KV_HEADS * B_HEAD_DIM,
            IDX_HEADS * IDX_DIM, IDX_DIM, IDX_HEADS, 2 * D_MODEL)
IN_WIDTH = sum(IN_SIZES)

kernel_name = 'hybrid_gmlp_dsa_gated_block'


def rmsnorm(x, g):
    xf = x.astype(jnp.float32)
    y = xf * lax.rsqrt(jnp.mean(xf * xf, axis=-1, keepdims=True) + EPS)
    return (y * g.astype(jnp.float32)).astype(x.dtype)


def rope_angles(positions, rot_dim):
    inv_freq = ROPE_THETA ** (-jnp.arange(0, rot_dim, 2, dtype=jnp.float32) / rot_dim)
    ang = positions.astype(jnp.float32)[..., None] * inv_freq
    return jnp.cos(ang), jnp.sin(ang)


def apply_partial_rope(x, cos, sin):
    r = 2 * cos.shape[-1]
    xr, xp = x[..., :r], x[..., r:]
    x1, x2 = xr[..., : r // 2], xr[..., r // 2:]
    c = cos[:, :, None, :].astype(x.dtype)
    s = sin[:, :, None, :].astype(x.dtype)
    return jnp.concatenate([x1 * c - x2 * s, x2 * c + x1 * s, xp], axis=-1)


def chunked_spatial_gating(z, norm_g, w_s, b_s):
    bsz, seq, _ = z.shape
    u, v = jnp.split(z, 2, axis=-1)
    v = rmsnorm(v, norm_g)
    v = v.reshape(bsz, seq // CHUNK, CHUNK, A_GROUPS, A_GROUP_DIM)
    causal = jnp.tril(jnp.ones((CHUNK, CHUNK), dtype=bool))
    w = jnp.where(causal[None], w_s, 0).astype(v.dtype)
    s = jnp.einsum('gts,bcsgd->bctgd', w, v) + b_s.T.astype(v.dtype)[None, None, :, :, None]
    return u * s.reshape(bsz, seq, A_WIDTH)


def dsa_attention(q, k, v, qi, ki, wi):
    bsz, seq = q.shape[0], q.shape[1]
    n_sel = min(TOPK_MAX, seq // 4)
    n_blocks = seq // Q_BLOCK
    grp = B_HEADS // B_KV_HEADS
    scale = B_HEAD_DIM ** -0.5
    idx_scale = (IDX_DIM ** -0.5) * (IDX_HEADS ** -0.5)
    key_pos = jnp.arange(seq)
    gather = jax.vmap(lambda table, ids: table[ids])

    def block(bi):
        start = bi * Q_BLOCK
        qb = lax.dynamic_slice_in_dim(q, start, Q_BLOCK, axis=1)
        qib = lax.dynamic_slice_in_dim(qi, start, Q_BLOCK, axis=1)
        wib = lax.dynamic_slice_in_dim(wi, start, Q_BLOCK, axis=1)
        qpos = start + jnp.arange(Q_BLOCK)
        causal = key_pos[None, :] <= qpos[:, None]
        dots = jnp.einsum('bthd,bsd->bths', qib, ki).astype(jnp.float32)
        iscore = jnp.einsum('bth,bths->bts', wib.astype(jnp.float32), jax.nn.relu(dots)) * idx_scale
        iscore = jnp.where(causal[None], iscore, -jnp.inf)
        _, sel = lax.top_k(iscore, n_sel)
        valid = sel <= qpos[None, :, None]
        ks = gather(k, sel)
        vs = gather(v, sel)
        qg = qb.reshape(bsz, Q_BLOCK, B_KV_HEADS, grp, B_HEAD_DIM)
        logits = jnp.einsum('btkgd,btskd->btkgs', qg, ks).astype(jnp.float32) * scale
        logits = jnp.where(valid[:, :, None, None, :], logits, -jnp.inf)
        p = jax.nn.softmax(logits, axis=-1).astype(v.dtype)
        o = jnp.einsum('btkgs,btskd->btkgd', p, vs)
        return o.reshape(bsz, Q_BLOCK, B_WIDTH)

    out = lax.map(block, jnp.arange(n_blocks))
    return out.transpose(1, 0, 2, 3).reshape(bsz, seq, B_WIDTH)


def memory_cross_attention(h, mem_n, wq, wk, wv, wo):
    bsz, seq, _ = h.shape
    m = mem_n.shape[1]
    q = (h @ wq).reshape(bsz, seq, X_HEADS, X_HEAD_DIM)
    k = (mem_n @ wk).reshape(bsz, m, X_HEADS, X_HEAD_DIM)
    v = (mem_n @ wv).reshape(bsz, m, X_HEADS, X_HEAD_DIM)
    logits = jnp.einsum('bshd,bmhd->bhsm', q, k).astype(jnp.float32) * (X_HEAD_DIM ** -0.5)
    p = jax.nn.softmax(logits, axis=-1).astype(v.dtype)
    o = jnp.einsum('bhsm,bmhd->bshd', p, v).reshape(bsz, seq, X_WIDTH)
    return o @ wo


def setup_inputs(seed: int = 0) -> dict:
    key = jax.random.key(seed)
    ks = jax.random.split(key, 24)

    def nrm(k, shape, scale):
        return jax.random.normal(k, shape, jnp.float32) * scale

    def gain(k, shape):
        return 1.0 + 0.02 * jax.random.normal(k, shape, jnp.float32)

    L = DEPTH
    x = jax.random.normal(ks[0], (BATCH, SEQ, D_MODEL), jnp.float32)
    mem = jax.random.normal(ks[1], (BATCH, MEM_LEN, D_MODEL), jnp.float32)
    offsets = jax.random.randint(ks[2], (BATCH, 1), 0, 4096, dtype=jnp.int32)
    positions = (offsets + jnp.arange(SEQ, dtype=jnp.int32)[None, :]).astype(jnp.int32)
    return {
        'x': x,
        'mem': mem,
        'positions': positions,
        'norm_mix_g': gain(ks[3], (L, D_MODEL)),
        'w_in': nrm(ks[4], (L, D_MODEL, IN_WIDTH), D_MODEL ** -0.5),
        'a_norm_g': gain(ks[5], (L, A_WIDTH)),
        'a_spatial_w': nrm(ks[6], (L, A_GROUPS, CHUNK, CHUNK), CHUNK ** -0.5),
        'a_spatial_b': gain(ks[7], (L, A_GROUPS, CHUNK)),
        'p_a': nrm(ks[8], (L, A_WIDTH, D_MODEL), A_WIDTH ** -0.5),
        'p_b': nrm(ks[9], (L, B_WIDTH, D_MODEL), B_WIDTH ** -0.5),
        'w_out': nrm(ks[10], (L, D_MODEL, D_MODEL), D_MODEL ** -0.5),
        'norm_x_g': gain(ks[11], (L, D_MODEL)),
        'norm_mem_g': gain(ks[12], (L, D_MODEL)),
        'xq_w': nrm(ks[13], (L, D_MODEL, X_WIDTH), D_MODEL ** -0.5),
        'xk_w': nrm(ks[14], (L, D_MODEL, X_WIDTH), D_MODEL ** -0.5),
        'xv_w': nrm(ks[15], (L, D_MODEL, X_WIDTH), D_MODEL ** -0.5),
        'xo_w': nrm(ks[16], (L, X_WIDTH, D_MODEL), X_WIDTH ** -0.5),
        'norm_ffn_g': gain(ks[17], (L, D_MODEL)),
        'ffn_w1': nrm(ks[18], (L, D_MODEL, FFN_HIDDEN), D_MODEL ** -0.5),
        'ffn_w3': nrm(ks[19], (L, D_MODEL, FFN_HIDDEN), D_MODEL ** -0.5),
        'ffn_w2': nrm(ks[20], (L, FFN_HIDDEN, D_MODEL), FFN_HIDDEN ** -0.5),
        'final_norm_g': gain(ks[21], (D_MODEL,)),
    }


def reference(x, mem, positions, norm_mix_g, w_in, a_norm_g, a_spatial_w, a_spatial_b,
              p_a, p_b, w_out, norm_x_g, norm_mem_g, xq_w, xk_w, xv_w, xo_w,
              norm_ffn_g, ffn_w1, ffn_w3, ffn_w2, final_norm_g):
    bsz, seq, _ = x.shape
    split_points = []
    acc = 0
    for sz in IN_SIZES[:-1]:
        acc += sz
        split_points.append(acc)
    cos_b, sin_b = rope_angles(positions, B_ROT)
    cos_i, sin_i = rope_angles(positions, IDX_ROT)

    for l in range(DEPTH):
        h = rmsnorm(x, norm_mix_g[l])
        proj = h @ w_in[l]
        za, q, k, v, qi, ki, wi, gates = jnp.split(proj, split_points, axis=-1)
        y_a = chunked_spatial_gating(jax.nn.gelu(za), a_norm_g[l], a_spatial_w[l], a_spatial_b[l])
        q = apply_partial_rope(q.reshape(bsz, seq, B_HEADS, B_HEAD_DIM), cos_b, sin_b)
        k = apply_partial_rope(k.reshape(bsz, seq, B_KV_HEADS, B_HEAD_DIM), cos_b, sin_b)
        v = v.reshape(bsz, seq, B_KV_HEADS, B_HEAD_DIM)
        qi = apply_partial_rope(qi.reshape(bsz, seq, IDX_HEADS, IDX_DIM), cos_i, sin_i)
        ki = apply_partial_rope(ki[:, :, None, :], cos_i, sin_i)[:, :, 0, :]
        y_b = dsa_attention(q, k, v, qi, ki, wi)
        g_a, g_b = jnp.split(jax.nn.sigmoid(gates), 2, axis=-1)
        merged = g_a * (y_a @ p_a[l]) + g_b * (y_b @ p_b[l])
        x = x + merged @ w_out[l]
        x = x + memory_cross_attention(rmsnorm(x, norm_x_g[l]), rmsnorm(mem, norm_mem_g[l]),
                                       xq_w[l], xk_w[l], xv_w[l], xo_w[l])
        h = rmsnorm(x, norm_ffn_g[l])
        x = x + (jax.nn.silu(h @ ffn_w1[l]) * (h @ ffn_w3[l])) @ ffn_w2[l]

    return rmsnorm(x, final_norm_g)
```

```cpp
#include <hip/hip_runtime.h>
#include <cstdio>
#include <cstdint>

#ifndef MK_N_LAUNCHES
#define MK_N_LAUNCHES 1
#endif

#ifndef DUP_PHASE
#define DUP_PHASE -1
#endif
#ifndef PH_MASK
#define PH_MASK 0xFFF
#endif
#define LAS __attribute__((address_space(3)))
#define GAS __attribute__((address_space(1)))
typedef unsigned short bf16_t;
typedef short bf16x8 __attribute__((ext_vector_type(8)));
typedef float f32x4 __attribute__((ext_vector_type(4)));
typedef float f32x16 __attribute__((ext_vector_type(16)));
typedef unsigned u32x4 __attribute__((ext_vector_type(4)));
typedef unsigned u32x2 __attribute__((ext_vector_type(2)));
typedef int v8i __attribute__((ext_vector_type(8)));
typedef __bf16 bf16x2_t __attribute__((ext_vector_type(2)));
typedef float f32x2_t __attribute__((ext_vector_type(2)));

constexpr int NB = 4, SEQ = 2048, M = NB * SEQ, DM = 4096, MEMR = 1024;
constexpr int NPROJ = 16640;
constexpr int C_U = 0, C_V = 2048, C_Q = 4096, C_K = 6144, C_VV = 6656, C_QI = 7168, C_KI = 8192, C_WI = 8256, C_GA = 8448, C_GB = 12544;
constexpr int FFN = 11008, N13 = 22016;
constexpr float EPS = 1e-6f;
constexpr int NPHASE = 12;

constexpr size_t MiB = 1u << 20;
constexpr size_t WS_CTL = 0, CTL_ZERO_BYTES = 1 * MiB;
constexpr int CW_BAR = 4096;
constexpr size_t CT_CVT = 32768;
constexpr size_t CT_SSQV = 65536, CT_SSQ1 = 98304, CT_SSQ2 = 131072, CT_SSQ3 = 163840;
constexpr size_t WS_RSTDX = 1 * MiB, WS_RSTDM = 1 * MiB + 65536, WS_ROPEB = 2 * MiB, WS_ROPEI = 3 * MiB, WS_WC = 3 * MiB + 524288, WS_MASK = 4 * MiB;
constexpr size_t WS_VT = 6 * MiB, WS_MEMB = 14 * MiB, WS_WIN = 22 * MiB, WS_PA = 152 * MiB, WS_PB = 168 * MiB, WS_WOUT = 184 * MiB;
constexpr size_t WS_WQ = 216 * MiB, WS_WK = 224 * MiB, WS_WV = 232 * MiB, WS_WO = 240 * MiB, WS_W13 = 248 * MiB, WS_W2 = 420 * MiB;
constexpr size_t WS_XB = 506 * MiB, WS_PROJ = 570 * MiB, WS_Y = 830 * MiB, WS_MRG = 894 * MiB, WS_KX = 958 * MiB, WS_VXT = 960 * MiB, WS_VTA = 962 * MiB, WS_Y8 = 994 * MiB, WS_END = 1010 * MiB;
constexpr size_t WS_WIN8 = 64 * MiB, WS_XB8 = WS_Y;
constexpr float F8_SA = 16.f, F8_SB = 1024.f, F8_INV = 1.f / (16.f * 1024.f), F8_SY = 64.f, F8_SPB = 512.f, F8_SYP = 64.f * 512.f, F8_IYP = 1.f / (64.f * 512.f);
constexpr size_t WS_HDN = WS_PROJ, WS_X1B = WS_Y, WS_X3B = WS_Y, WS_X2B = WS_XB, WS_QX0 = WS_MRG, WS_QX1 = WS_MRG + 16 * MiB, WS_OX = WS_MRG + 32 * MiB;
static_assert(WS_WIN + (size_t)NPROJ * DM * 2 <= WS_PA && WS_W13 + (size_t)N13 * DM * 2 <= WS_W2 && WS_W2 + (size_t)DM * FFN * 2 <= WS_XB, "weights map");
static_assert(WS_PROJ + (size_t)M * NPROJ * 2 <= WS_Y && WS_HDN + (size_t)M * FFN * 2 <= WS_Y, "proj map");

constexpr int RING_BYTES = 139264;
constexpr int LDSCTL_OFF = RING_BYTES, LDS_BYTES = RING_BYTES + 512;

__device__ __forceinline__ unsigned pk2(float lo, float hi) { f32x2_t v = {lo, hi}; bf16x2_t b = __builtin_convertvector(v, bf16x2_t); return __builtin_bit_cast(unsigned, b); }
__device__ __forceinline__ float bf_lo(unsigned w) { return __uint_as_float(w << 16); }
__device__ __forceinline__ float bf_hi(unsigned w) { return __uint_as_float(w & 0xffff0000u); }
__device__ __forceinline__ float bf1(bf16_t b) { return __uint_as_float(((unsigned)b) << 16); }
__device__ __forceinline__ void unpack8(const u32x4 r, float (&f)[8]) { f[0] = bf_lo(r.x); f[1] = bf_hi(r.x); f[2] = bf_lo(r.y); f[3] = bf_hi(r.y); f[4] = bf_lo(r.z); f[5] = bf_hi(r.z); f[6] = bf_lo(r.w); f[7] = bf_hi(r.w); }
__device__ __forceinline__ u32x4 pack8(const float (&f)[8]) { u32x4 w; w.x = pk2(f[0], f[1]); w.y = pk2(f[2], f[3]); w.z = pk2(f[4], f[5]); w.w = pk2(f[6], f[7]); return w; }
__device__ __forceinline__ unsigned pk4_fp8(float a, float b, float c, float d) { int w = 0; w = __builtin_amdgcn_cvt_pk_fp8_f32(a, b, w, false); w = __builtin_amdgcn_cvt_pk_fp8_f32(c, d, w, true); return (unsigned)w; }
__device__ __forceinline__ float sigmoidf_(float x) { return __builtin_amdgcn_rcpf(1.f + __builtin_amdgcn_exp2f(-1.44269504f * x)); }
__device__ __forceinline__ float gelu_tanh(float x) { const float z = 1.5957691216f * x * (1.f + 0.044715f * x * x); return x * sigmoidf_(z); }
__device__ __forceinline__ float wave_sum(float v) {
#pragma unroll
    for (int o = 1; o < 64; o <<= 1) v += __shfl_xor(v, o);
    return v;
}
__device__ __forceinline__ float shx(float v, int lane, int m) { return __int_as_float(__builtin_amdgcn_ds_bpermute(((lane ^ m) & 63) << 2, __float_as_int(v))); }
__device__ __forceinline__ float xmax32(float t) { const auto r = __builtin_amdgcn_permlane32_swap(__float_as_uint(t), __float_as_uint(t), false, false); return fmaxf(__uint_as_float(r[0]), __uint_as_float(r[1])); }
__device__ __forceinline__ float xsum32(float t) { const auto r = __builtin_amdgcn_permlane32_swap(__float_as_uint(t), __float_as_uint(t), false, false); return __uint_as_float(r[0]) + __uint_as_float(r[1]); }
#define LDS_WAIT() asm volatile("s_waitcnt lgkmcnt(0)" ::: "memory")
#define MFMA32(a, b, c) __builtin_amdgcn_mfma_f32_32x32x16_bf16((a), (b), (c), 0, 0, 0)
#define MFMA16(a, b, c) __builtin_amdgcn_mfma_f32_16x16x32_bf16((a), (b), (c), 0, 0, 0)

#define XB_TMO      128
#define XB_XCNT(j)  (256  + 64 * (j))
#define XB_XSUB(j)  (1280 + 64 * (j))
#define XB_XGEN(j)  (2304 + 64 * (j))
#define XB_TOP      3328
#define XB_TOPGEN   3392
#define XCD_BAR_WORDS 3456
#define XB_SPIN_CAP (1u << 18)
__device__ __forceinline__ unsigned xb_ld(unsigned* p)              { return __hip_atomic_load(p, __ATOMIC_RELAXED, __HIP_MEMORY_SCOPE_AGENT); }
__device__ __forceinline__ unsigned xb_add(unsigned* p, unsigned v) { return __hip_atomic_fetch_add(p, v, __ATOMIC_RELAXED, __HIP_MEMORY_SCOPE_AGENT); }
__device__ __forceinline__ unsigned xb_xcc_id() { return (unsigned)__builtin_amdgcn_s_getreg((3 << 11) | 20) & 0xFu; }
#define XB_SPIN(cond, bar) do { unsigned _sp = 0; while (cond) { __builtin_amdgcn_s_sleep(1); \
    if ((++_sp & 255u) == 0u) { if (xb_ld(&(bar)[XB_TMO])) break; if (_sp > XB_SPIN_CAP) { atomicAdd(&(bar)[XB_TMO], 1u); break; } } } } while (0)
struct XcdBarrier { unsigned* bar; unsigned x; volatile LAS unsigned* st; };
__device__ __forceinline__ XcdBarrier xcd_barrier_post(unsigned* bar, volatile LAS unsigned* st) {
    XcdBarrier b; b.bar = bar; b.x = xb_xcc_id(); b.st = st;
    if (threadIdx.x == 0) (void)xb_add(&bar[XB_XCNT(b.x)], 1u);
    return b;
}
__device__ __forceinline__ void xcd_barrier_complete(unsigned* bar, unsigned x, unsigned& nloc, unsigned& nx) {
    const unsigned G = gridDim.x * gridDim.y * gridDim.z;
    unsigned sum, cnt, mine, sp = 0u;
    for (;;) {
        sum = 0u; cnt = 0u; mine = 0u;
#pragma unroll
        for (unsigned j = 0; j < 16; ++j) { const unsigned c = xb_ld(&bar[XB_XCNT(j)]); sum += c; cnt += (c > 0u) ? 1u : 0u; mine = (j == x) ? c : mine; }
        if (sum == G) break;
        __builtin_amdgcn_s_sleep(1);
        if ((++sp & 255u) == 0u) { if (xb_ld(&bar[XB_TMO])) break; if (sp > XB_SPIN_CAP) { atomicAdd(&bar[XB_TMO], 1u); break; } }
    }
    nloc = mine > 0u ? mine : 1u; nx = cnt > 0u ? cnt : 1u;
}
__device__ __forceinline__ void xcd_barrier(const XcdBarrier& b) {
    asm volatile("s_waitcnt vmcnt(0)" ::: "memory");
    __syncthreads();
    if (threadIdx.x == 0) {
        unsigned* bar = b.bar;
        __builtin_amdgcn_s_waitcnt(0);
        unsigned nloc = b.st[0], nx = b.st[1];
        if (nloc == 0u) { xcd_barrier_complete(bar, b.x, nloc, nx); b.st[0] = nloc; b.st[1] = nx; }
        const unsigned old = xb_add(&bar[XB_XSUB(b.x)], 1u);
        const unsigned gen = old / nloc;
        if (old + 1u == (gen + 1u) * nloc) {
            __builtin_amdgcn_fence(__ATOMIC_RELEASE, "agent");
            asm volatile("s_waitcnt vmcnt(0)" ::: "memory");
            const unsigned og = xb_add(&bar[XB_TOP], 1u);
            const unsigned tg = og / nx;
            if (og + 1u == (tg + 1u) * nx) xb_add(&bar[XB_TOPGEN], 1u);
            else XB_SPIN(xb_ld(&bar[XB_TOPGEN]) == tg, bar);
            __builtin_amdgcn_fence(__ATOMIC_ACQUIRE, "agent");
            xb_add(&bar[XB_XGEN(b.x)], 1u);
            asm volatile("s_waitcnt vmcnt(0)" ::: "memory");
        } else {
            XB_SPIN(xb_ld(&bar[XB_XGEN(b.x)]) == gen, bar);
            __builtin_amdgcn_fence(__ATOMIC_ACQUIRE, "agent");
            asm volatile("s_waitcnt vmcnt(0)" ::: "memory");
        }
    }
    __syncthreads();
}

namespace pg8 {
constexpr int BM = 256, BK = 64, HALF = 128, HTB = HALF * BK * 2, STAGE_BYTES = 8 * HTB;
__device__ __forceinline__ int lds_byte(int r, int c) { const int st = (r >> 4) * 2 + (c >> 5), rr = r & 15, cc = c & 31, ob = rr * 64 + cc * 2; return st * 1024 + (ob ^ (((ob >> 9) & 1) << 5)); }
__device__ __forceinline__ void stage_rc(int b, int& R, int& C) { const int st = b / 1024, sb = b % 1024, swz = sb ^ (((sb >> 9) & 1) << 5); R = (st >> 1) * 16 + swz / 64; C = (st & 1) * 32 + (swz % 64) / 2; }
__device__ __forceinline__ int perm32(int rho) { const int n = rho >> 4, i = rho & 15; return 8 * (i >> 2) + 4 * n + (i & 3); }
struct Unit { const char* A; const char* B; int pm, pn, kind; };
__device__ __forceinline__ void tile_of(int L, int nM, int nN, int& pm, int& pn) {
    const int nwg = nM * nN; int wgid = L;
    { const int q = nwg / 8, r = nwg % 8, xcd = wgid % 8, off = wgid / 8; wgid = (xcd < r ? xcd * (q + 1) : r * (q + 1) + (xcd - r) * q) + off; }
    const int nig = 8 * nN, gid = wgid / nig, fm = gid * 8, gsz = (nM - fm) < 8 ? (nM - fm) : 8;
    pm = fm + ((wgid % nig) % gsz); pn = (wgid % nig) / gsz;
}
template <bool F8, class Epi, class Sched>
__device__ __forceinline__ void gemm_phase_acc(LAS unsigned char* lds, const int K, const int lda, const int ldb, const Sched& S, const Epi& E, f32x4 (&acc)[2][2][4][2], const bool zero_first) {
    int tid = threadIdx.x; asm volatile("" : "+v"(tid));
    const int wid = __builtin_amdgcn_readfirstlane(tid >> 6), lane = tid & 63, wr = wid >> 2, wc = wid & 3, fr = lane & 15, fq = lane >> 4;
    constexpr int EB = F8 ? 1 : 2;
    const int nt = K * EB / (BK * 2);
    unsigned voffA[2], voffB[2];
#pragma unroll
    for (int i = 0; i < 2; ++i) { int R, C; stage_rc(tid * 16 + i * 8192, R, C); const int Rb = (R & ~31) + perm32(R & 31);
        voffA[i] = (unsigned)(R * lda * EB + C * 2); voffB[i] = (unsigned)(Rb * ldb * EB + C * 2); }
    const size_t kstep = (size_t)(BK * 2);
    const size_t hstepA = (size_t)HALF * lda * EB, hstepB = (size_t)HALF * ldb * EB;
    const unsigned ldsw = (unsigned)wid * 1024u;
    const unsigned ldsbase = (unsigned)(unsigned long)lds;
    const int aoff = F8 ? lds_byte(wr * 64 + fr, fq * 16) : lds_byte(wr * 64 + fr, fq * 8), boff = F8 ? lds_byte(wc * 32 + fr, fq * 16) : lds_byte(wc * 32 + fr, fq * 8);
    constexpr int KOFF = F8 ? 16 : 1024;
    const int sw8 = F8 ? 16 * (fq & 1) : 0, aoffx = aoff + sw8, boffx = boff + sw8, aoffy = aoff + KOFF - sw8, boffy = boff + KOFF - sw8;
#define PG8_SA(b, h) (((b) * 2 + (h)) * HTB)
#define PG8_SB(b, h) ((4 + (b) * 2 + (h)) * HTB)
#define PG8_STAGE(bufoff, gbase, voff) do { _Pragma("unroll") for (int _i = 0; _i < 2; ++_i) \
        __builtin_amdgcn_global_load_lds((const unsigned*)((const char*)(gbase) + (voff)[_i]), (LAS unsigned*)(lds + (bufoff) + ldsw + _i * 8192), 16, 0, 0); } while (0)
#define PG8_STAGE8(bufoff, gbase, voff) do { _Pragma("unroll") for (int _i = 0; _i < 2; ++_i) { unsigned _keep; \
        asm volatile("s_mov_b32 %0, m0\n\ts_mov_b32 m0, %3\n\ts_nop 0\n\tglobal_load_lds_dwordx4 %1, %2\n\ts_mov_b32 m0, %0" : "=&s"(_keep) : "v"((voff)[_i]), "s"((const char*)(gbase)), "s"(ldsbase + (unsigned)(bufoff) + ldsw + _i * 8192u)); } } while (0)
#define PG8_LDA(dst, b, h) do { _Pragma("unroll") for (int m = 0; m < 4; ++m) _Pragma("unroll") for (int k = 0; k < 2; ++k) dst[m][k] = *(const LAS bf16x8*)(lds + PG8_SA(b, h) + aoff + m * 2048 + k * KOFF); } while (0)
#define PG8_LDB(dst, b, h) do { _Pragma("unroll") for (int n = 0; n < 2; ++n) _Pragma("unroll") for (int k = 0; k < 2; ++k) dst[n][k] = *(const LAS bf16x8*)(lds + PG8_SB(b, h) + boff + n * 2048 + k * KOFF); } while (0)
#define PG8_MMA(ai, bj, At, Bt) do { __builtin_amdgcn_s_setprio(1); _Pragma("unroll") for (int m = 0; m < 4; ++m) _Pragma("unroll") for (int n = 0; n < 2; ++n) { \
        if constexpr (F8) { const u32x4 _b0 = __builtin_bit_cast(u32x4, Bt[n][0]), _b1 = __builtin_bit_cast(u32x4, Bt[n][1]), _a0 = __builtin_bit_cast(u32x4, At[m][0]), _a1 = __builtin_bit_cast(u32x4, At[m][1]); \
            const v8i _bb = {(int)_b0.x, (int)_b0.y, (int)_b0.z, (int)_b0.w, (int)_b1.x, (int)_b1.y, (int)_b1.z, (int)_b1.w}, _aa = {(int)_a0.x, (int)_a0.y, (int)_a0.z, (int)_a0.w, (int)_a1.x, (int)_a1.y, (int)_a1.z, (int)_a1.w}; \
            acc[ai][bj][m][n] = __builtin_amdgcn_mfma_scale_f32_16x16x128_f8f6f4(_bb, _aa, acc[ai][bj][m][n], 0, 0, 0, 0, 0, 0); } \
        else { _Pragma("unroll") for (int k = 0; k < 2; ++k) acc[ai][bj][m][n] = __builtin_amdgcn_mfma_f32_16x16x32_bf16(Bt[n][k], At[m][k], acc[ai][bj][m][n], 0, 0, 0); } } \
        __builtin_amdgcn_s_setprio(0); } while (0)
#define PG8_WAIT_V(n) asm volatile("s_waitcnt vmcnt(" #n ")" ::: "memory")
#define PG8_WAIT_L(n) asm volatile("s_waitcnt lgkmcnt(" #n ")" ::: "memory")
#define PG8_BAR __builtin_amdgcn_s_barrier()
#define PG8_SCHED __builtin_amdgcn_sched_barrier(0)
    Unit cur, nxt; int ui = 0;
    if (!S.next(0, cur)) return;
    if (zero_first) {
#pragma unroll
    for (int a = 0; a < 2; ++a)
#pragma unroll
        for (int b = 0; b < 2; ++b)
#pragma unroll
            for (int m = 0; m < 4; ++m)
#pragma unroll
                for (int n = 0; n < 2; ++n) acc[a][b][m][n] = (f32x4){0.f, 0.f, 0.f, 0.f};
    }
    bf16x8 At[4][2], B0[2][2], B1[2][2];
    const char* cA = cur.A; const char* cB = cur.B;
    if constexpr (F8) {
    PG8_STAGE8(PG8_SB(0, 0), cB, voffB); PG8_STAGE8(PG8_SB(0, 1), cB + hstepB, voffB); PG8_STAGE8(PG8_SA(0, 0), cA, voffA); PG8_STAGE8(PG8_SA(0, 1), cA + hstepA, voffA);
    if (wr == 1) PG8_BAR;
    PG8_WAIT_V(2); PG8_BAR;
    PG8_STAGE8(PG8_SB(1, 0), cB + kstep, voffB); PG8_STAGE8(PG8_SA(1, 0), cA + kstep, voffA); PG8_STAGE8(PG8_SB(1, 1), cB + hstepB + kstep, voffB);
    PG8_WAIT_V(6); PG8_BAR;
    } else {
    PG8_STAGE(PG8_SB(0, 0), cB, voffB); PG8_STAGE(PG8_SB(0, 1), cB + hstepB, voffB); PG8_STAGE(PG8_SA(0, 0), cA, voffA); PG8_STAGE(PG8_SA(0, 1), cA + hstepA, voffA);
    if (wr == 1) PG8_BAR;
    PG8_WAIT_V(2); PG8_BAR;
    PG8_STAGE(PG8_SB(1, 0), cB + kstep, voffB); PG8_STAGE(PG8_SA(1, 0), cA + kstep, voffA); PG8_STAGE(PG8_SB(1, 1), cB + hstepB + kstep, voffB);
    PG8_WAIT_V(6); PG8_BAR;
    }
    for (;;) {
        const bool has_next = S.next(ui + 1, nxt);
        const char* nA = has_next ? nxt.A : cA; const char* nB = has_next ? nxt.B : cB;
        if constexpr (F8) {
        __builtin_amdgcn_s_waitcnt(0x0F70);
#pragma clang loop unroll(disable)
        for (int t = 0; t < nt; ++t) {
            const unsigned bo = (unsigned)(t & 1) * 32768u, bo1 = bo ^ 32768u;
            const char* a1 = (t + 1 < nt) ? cA + (size_t)(t + 1) * kstep : nA + (size_t)(t + 1 - nt) * kstep;
            const char* a2 = (t + 2 < nt) ? cA + (size_t)(t + 2) * kstep : nA + (size_t)(t + 2 - nt) * kstep;
            const char* b2 = (t + 2 < nt) ? cB + (size_t)(t + 2) * kstep : nB + (size_t)(t + 2 - nt) * kstep;
#define PG8_RLD(dst, NR, off, base) do { _Pragma("unroll") for (int q = 0; q < NR; ++q) _Pragma("unroll") for (int k = 0; k < 2; ++k) dst[q][k] = *(const LAS bf16x8*)(lds + (k ? base##y : base##x) + (off) + q * 2048); } while (0)
            PG8_RLD(B0, 2, bo + 4 * HTB, boff); PG8_RLD(B1, 2, bo + 5 * HTB, boff); PG8_SCHED; PG8_RLD(At, 4, bo, aoff); PG8_STAGE8(bo1 + HTB, a1 + hstepA, voffA);
            PG8_WAIT_V(8); PG8_WAIT_L(0); PG8_BAR; PG8_MMA(0, 0, At, B0); PG8_MMA(0, 1, At, B1); PG8_BAR; PG8_SCHED;
            PG8_RLD(At, 4, bo + HTB, aoff); PG8_STAGE8(bo + 4 * HTB, b2, voffB); PG8_STAGE8(bo + 5 * HTB, b2 + hstepB, voffB); PG8_STAGE8(bo, a2, voffA);
            PG8_WAIT_V(8); PG8_WAIT_L(0); PG8_BAR; PG8_MMA(1, 0, At, B0); PG8_MMA(1, 1, At, B1); PG8_BAR; PG8_SCHED;
#undef PG8_RLD
        }
        } else
        for (int t = 0; t < nt; t += 2) {
            const bool last = (t == nt - 2);
            const char* a1 = cA + (size_t)(t + 1) * kstep;
            const char* a2 = last ? nA : cA + (size_t)(t + 2) * kstep; const char* b2 = last ? nB : cB + (size_t)(t + 2) * kstep;
            const char* a3 = a2 + kstep; const char* b3 = b2 + kstep;
            PG8_LDB(B0, 0, 0); PG8_LDB(B1, 0, 1); PG8_SCHED; PG8_LDA(At, 0, 0); PG8_STAGE(PG8_SA(1, 1), a1 + hstepA, voffA);
            PG8_WAIT_V(8); PG8_WAIT_L(0); PG8_BAR; PG8_MMA(0, 0, At, B0); PG8_MMA(0, 1, At, B1); PG8_BAR; PG8_SCHED;
            PG8_LDA(At, 0, 1); PG8_STAGE(PG8_SB(0, 0), b2, voffB); PG8_STAGE(PG8_SB(0, 1), b2 + hstepB, voffB); PG8_STAGE(PG8_SA(0, 0), a2, voffA);
            PG8_WAIT_V(8); PG8_WAIT_L(0); PG8_BAR; PG8_MMA(1, 0, At, B0); PG8_MMA(1, 1, At, B1); PG8_BAR; PG8_SCHED;
            PG8_LDB(B0, 1, 0); PG8_LDB(B1, 1, 1); PG8_SCHED; PG8_LDA(At, 1, 0); PG8_STAGE(PG8_SA(0, 1), a2 + hstepA, voffA);
            PG8_WAIT_V(8); PG8_WAIT_L(0); PG8_BAR; PG8_MMA(0, 0, At, B0); PG8_MMA(0, 1, At, B1); PG8_BAR; PG8_SCHED;
            PG8_LDA(At, 1, 1); PG8_STAGE(PG8_SB(1, 0), b3, voffB); PG8_STAGE(PG8_SB(1, 1), b3 + hstepB, voffB); PG8_STAGE(PG8_SA(1, 0), a3, voffA);
            PG8_WAIT_V(8); PG8_WAIT_L(0); PG8_BAR; PG8_MMA(1, 0, At, B0); PG8_MMA(1, 1, At, B1); PG8_BAR; PG8_SCHED;
        }
        if (wr == 0) PG8_BAR;
        bool keep = false;
        int tz = tid; asm volatile("" : "+v"(tz));
        const int fr2 = tz & 15, fq2 = (tz & 63) >> 4;
        if constexpr (Epi::CONT) { keep = (cur.kind == 0); if (keep) E.mid(acc, cur, wr, wc, fr2, fq2); else E(acc, cur, wr, wc, fr2, fq2); }
        else E(acc, cur, wr, wc, fr2, fq2);
        if (!has_next) break;
        if (!keep) {
#pragma unroll
        for (int a = 0; a < 2; ++a)
#pragma unroll
            for (int b = 0; b < 2; ++b)
#pragma unroll
                for (int m = 0; m < 4; ++m)
#pragma unroll
                    for (int n = 0; n < 2; ++n) acc[a][b][m][n] = (f32x4){0.f, 0.f, 0.f, 0.f};
        }
        cur = nxt; cA = nA; cB = nB; ++ui;
        if (wr == 1) PG8_BAR;
    }
    PG8_WAIT_V(0);
    PG8_BAR;
#undef PG8_SA
#undef PG8_SB
#undef PG8_STAGE
#undef PG8_STAGE8
#undef PG8_LDA
#undef PG8_LDB
#undef PG8_MMA
#undef PG8_WAIT_V
#undef PG8_WAIT_L
#undef PG8_BAR
#undef PG8_SCHED
}
template <bool F8, class Epi, class Sched>
__device__ __forceinline__ void gemm_phase(LAS unsigned char* lds, const int K, const int lda, const int ldb, const Sched& S, const Epi& E) {
    f32x4 acc[2][2][4][2];
    gemm_phase_acc<F8>(lds, K, lda, ldb, S, E, acc, true);
}
}
using pg8::Unit;

struct Params {
    const float *x, *mem; const int* pos;
    const float *norm_mix_g, *w_in, *a_norm_g, *a_sw, *a_sb, *p_a, *p_b, *w_out, *norm_x_g, *norm_mem_g, *xq, *xk, *xv, *xo, *norm_ffn_g, *w1, *w3, *w2, *final_g;
    float* out; unsigned char* ws;
    int ph_lo, ph_hi;
};
struct Frame {
    LAS unsigned char* lds;
    int tid, lane, wave, G, bid;
    unsigned char* ws;
};
#define F_PROJ ((bf16_t*)(F.ws + WS_PROJ))
#define F_VT ((bf16_t*)(F.ws + WS_VT))
#define F_Y ((bf16_t*)(F.ws + WS_Y))
#define F_MRG ((bf16_t*)(F.ws + WS_MRG))
#define F_SSQV ((float*)(F.ws + CT_SSQV))
#define F_SSQ1 ((float*)(F.ws + CT_SSQ1))
#define F_SSQ2 ((float*)(F.ws + CT_SSQ2))
#define F_SSQ3 ((float*)(F.ws + CT_SSQ3))
#define F_RSTDX ((float*)(F.ws + WS_RSTDX))
#define F_RSTDM ((float*)(F.ws + WS_RSTDM))
#define F_ROPEB ((float*)(F.ws + WS_ROPEB))
#define F_ROPEI ((float*)(F.ws + WS_ROPEI))
#define F_MASK ((unsigned*)(F.ws + WS_MASK))

#define EPI_ROW(ai, m) (u.pm * 256 + (ai) * 128 + wr * 64 + (m) * 16 + fr)
#define EPI_COL(bj) (u.pn * 256 + (bj) * 128 + wc * 32 + 8 * fq)
#define EPI_LOAD8(v, ai, bj, m, s) do { const f32x4 _a = acc[ai][bj][m][0], _b = acc[ai][bj][m][1]; v[0] = _a[0] * (s); v[1] = _a[1] * (s); v[2] = _a[2] * (s); v[3] = _a[3] * (s); v[4] = _b[0] * (s); v[5] = _b[1] * (s); v[6] = _b[2] * (s); v[7] = _b[3] * (s); } while (0)

template <int PART>
struct EpiProj {
    static constexpr bool CONT = false;
    bf16_t* proj; bf16_t* vT; bf16_t* vTa; const float* rstd_x; float* ssq_v; const float* rope_b; const float* rope_i; bf16_t* kx; bf16_t* vxT; const float* rstd_m; float asc;
    __device__ __forceinline__ void operator()(const f32x4 (&acc)[2][2][4][2], const Unit& u, int wr, int wc, int fr, int fq) const {
        if constexpr (PART == 2) {
        if (u.kind == 1) {
#pragma unroll
            for (int ai = 0; ai < 2; ++ai)
#pragma unroll
                for (int m = 0; m < 4; ++m) { const int row = EPI_ROW(ai, m); const float rs = rstd_m[row];
#pragma unroll
                    for (int bj = 0; bj < 2; ++bj) { float v[8]; EPI_LOAD8(v, ai, bj, m, rs); *(u32x4*)(kx + (size_t)row * 1024 + EPI_COL(bj)) = pack8(v); } }
            return;
        }
        if (u.kind == 2) {
#pragma unroll
            for (int bj = 0; bj < 2; ++bj) { const int c0 = EPI_COL(bj); const f32x4 s0 = *(const f32x4*)(rstd_m + c0), s1 = *(const f32x4*)(rstd_m + c0 + 4);
#pragma unroll
                for (int ai = 0; ai < 2; ++ai)
#pragma unroll
                    for (int m = 0; m < 4; ++m) { const int row = EPI_ROW(ai, m); float v[8]; EPI_LOAD8(v, ai, bj, m, 1.f);
                        v[0] *= s0[0]; v[1] *= s0[1]; v[2] *= s0[2]; v[3] *= s0[3]; v[4] *= s1[0]; v[5] *= s1[1]; v[6] *= s1[2]; v[7] *= s1[3];
                        *(u32x4*)(vxT + (size_t)row * 1024 + c0) = pack8(v); } }
            return;
        }
        } else {
        const int pn = (PART == 0 && u.pn >= 16) ? u.pn + 12 : u.pn;
        if (PART == 0 && u.pn < 16) {
#pragma unroll
            for (int ai = 0; ai < 2; ++ai)
#pragma unroll
                for (int m = 0; m < 4; ++m) { const int row = EPI_ROW(ai, m); const float rs = rstd_x[row] * asc; float ss = 0.f;
#pragma unroll
                    for (int bj = 0; bj < 2; ++bj) { float v[8]; EPI_LOAD8(v, ai, bj, m, rs);
#pragma unroll
                        for (int j = 0; j < 8; ++j) { v[j] = gelu_tanh(v[j]); ss += v[j] * v[j]; }
                        const u32x4 w = pack8(v);
                        if (pn < 8) *(u32x4*)(proj + (size_t)row * NPROJ + EPI_COL(bj)) = w;
                        else { const int cc = (pn - 8) * 256 + bj * 128 + wc * 32 + 8 * fq; bf16_t* tp = vTa + ((size_t)((row >> 11) * 2048 + cc)) * 2048 + (row & 2047);
                            tp[0] = (bf16_t)(w.x & 0xffffu); tp[2048] = (bf16_t)(w.x >> 16); tp[2 * 2048] = (bf16_t)(w.y & 0xffffu); tp[3 * 2048] = (bf16_t)(w.y >> 16);
                            tp[4 * 2048] = (bf16_t)(w.z & 0xffffu); tp[5 * 2048] = (bf16_t)(w.z >> 16); tp[6 * 2048] = (bf16_t)(w.w & 0xffffu); tp[7 * 2048] = (bf16_t)(w.w >> 16); } }
                    if (pn >= 8) { ss += __shfl_xor(ss, 16); ss += __shfl_xor(ss, 32); if (fq == 0) atomicAdd(ssq_v + row, ss); } }
        } else if (PART == 1 && pn < 26) {
#pragma unroll
            for (int ai = 0; ai < 2; ++ai)
#pragma unroll
                for (int m = 0; m < 4; ++m) { const int row = EPI_ROW(ai, m); const float rs = rstd_x[row] * asc;
                    const f32x4 c0 = *(const f32x4*)(rope_b + (size_t)row * 32 + 8 * (fq & 1)), c1 = *(const f32x4*)(rope_b + (size_t)row * 32 + 8 * (fq & 1) + 4);
                    const f32x4 s0 = *(const f32x4*)(rope_b + (size_t)row * 32 + 16 + 8 * (fq & 1)), s1 = *(const f32x4*)(rope_b + (size_t)row * 32 + 16 + 8 * (fq & 1) + 4);
                    const float cs[8] = {c0[0], c0[1], c0[2], c0[3], c1[0], c1[1], c1[2], c1[3]}, sn[8] = {s0[0], s0[1], s0[2], s0[3], s1[0], s1[1], s1[2], s1[3]};
#pragma unroll
                    for (int bj = 0; bj < 2; ++bj) { float v[8]; EPI_LOAD8(v, ai, bj, m, rs);
                        if (wc == 0) {
#pragma unroll
                            for (int j = 0; j < 8; ++j) { const float o = __shfl_xor(v[j], 32); v[j] = (fq < 2) ? (v[j] * cs[j] - o * sn[j]) : (v[j] * cs[j] + o * sn[j]); } }
                        *(u32x4*)(proj + (size_t)row * NPROJ + EPI_COL(bj)) = pack8(v); } }
        } else if (PART == 1 && pn < 28) {
#pragma unroll
            for (int ai = 0; ai < 2; ++ai)
#pragma unroll
                for (int m = 0; m < 4; ++m) { const int row = EPI_ROW(ai, m); const float rs = rstd_x[row] * asc; const int b = row >> 11, s = row & 2047;
#pragma unroll
                    for (int bj = 0; bj < 2; ++bj) { float v[8]; EPI_LOAD8(v, ai, bj, m, rs); const u32x4 w = pack8(v);
                        *(u32x4*)(proj + (size_t)row * NPROJ + EPI_COL(bj)) = w;
                        const int cc = (pn - 26) * 256 + bj * 128 + wc * 32 + 8 * fq; bf16_t* tp = vT + ((size_t)(b * 512 + cc)) * 2048 + s;
                        tp[0] = (bf16_t)(w.x & 0xffffu); tp[2048] = (bf16_t)(w.x >> 16); tp[2 * 2048] = (bf16_t)(w.y & 0xffffu); tp[3 * 2048] = (bf16_t)(w.y >> 16);
                        tp[4 * 2048] = (bf16_t)(w.z & 0xffffu); tp[5 * 2048] = (bf16_t)(w.z >> 16); tp[6 * 2048] = (bf16_t)(w.w & 0xffffu); tp[7 * 2048] = (bf16_t)(w.w >> 16); } }
        } else if (PART == 0) {
#pragma unroll
            for (int ai = 0; ai < 2; ++ai)
#pragma unroll
                for (int m = 0; m < 4; ++m) { const int row = EPI_ROW(ai, m); const float rs = rstd_x[row] * asc;
                    const f32x4 c0 = *(const f32x4*)(rope_i + (size_t)row * 16), c1 = *(const f32x4*)(rope_i + (size_t)row * 16 + 4), s0 = *(const f32x4*)(rope_i + (size_t)row * 16 + 8), s1 = *(const f32x4*)(rope_i + (size_t)row * 16 + 12);
                    const float cs[8] = {c0[0], c0[1], c0[2], c0[3], c1[0], c1[1], c1[2], c1[3]}, sn[8] = {s0[0], s0[1], s0[2], s0[3], s1[0], s1[1], s1[2], s1[3]};
#pragma unroll
                    for (int bj = 0; bj < 2; ++bj) { float v[8]; EPI_LOAD8(v, ai, bj, m, rs);
                        const bool rot = (pn < 32) ? ((wc & 1) == 0) : (bj == 0 && wc == 0);
                        if (rot) {
#pragma unroll
                            for (int j = 0; j < 8; ++j) { const float o = __shfl_xor(v[j], 16); v[j] = (fq == 0) ? (v[j] * cs[j] - o * sn[j]) : ((fq == 1) ? (v[j] * cs[j] + o * sn[j]) : v[j]); } }
                        *(u32x4*)(proj + (size_t)row * NPROJ + pn * 256 + bj * 128 + wc * 32 + 8 * fq) = pack8(v);   } }
        } else {
            const bool isa = u.pn >= 200; const int gt = isa ? u.pn - 200 : u.pn - 100; bf16_t* gp = proj + (isa ? C_GA : C_GB) + gt * 256;
#pragma unroll
            for (int ai = 0; ai < 2; ++ai)
#pragma unroll
                for (int m = 0; m < 4; ++m) { const int row = EPI_ROW(ai, m); const float rs = rstd_x[row] * asc;
#pragma unroll
                    for (int bj = 0; bj < 2; ++bj) { float v[8]; EPI_LOAD8(v, ai, bj, m, rs);
#pragma unroll
                        for (int j = 0; j < 8; ++j) { const float g = sigmoidf_(v[j]); v[j] = isa ? g : fmaxf(g, 1.0e-20f); }
                        *(u32x4*)(gp + (size_t)row * NPROJ + bj * 128 + wc * 32 + 8 * fq) = pack8(v); } }
        }
        }
    }
};
struct EpiMerge {
    static constexpr bool CONT = true;
    bf16_t* mrg; const bf16_t* proj;
    __device__ __forceinline__ void mid(f32x4 (&acc)[2][2][4][2], const Unit& u, int wr, int wc, int fr, int fq) const {
#pragma unroll
        for (int ai = 0; ai < 2; ++ai) { u32x4 ga[4][2], gb[4][2];
#pragma unroll
            for (int m = 0; m < 4; ++m) { const int row = EPI_ROW(ai, m);
#pragma unroll
                for (int bj = 0; bj < 2; ++bj) { ga[m][bj] = *(const u32x4*)(proj + (size_t)row * NPROJ + C_GA + EPI_COL(bj)); gb[m][bj] = *(const u32x4*)(proj + (size_t)row * NPROJ + C_GB + EPI_COL(bj)); } }
#pragma unroll
            for (int m = 0; m < 4; ++m)
#pragma unroll
                for (int bj = 0; bj < 2; ++bj) { float g[8], h[8]; unpack8(ga[m][bj], g); unpack8(gb[m][bj], h);
#pragma unroll
                    for (int j = 0; j < 8; ++j) g[j] *= F8_SYP * __builtin_amdgcn_rcpf(h[j]);
                    acc[ai][bj][m][0] *= (f32x4){g[0], g[1], g[2], g[3]}; acc[ai][bj][m][1] *= (f32x4){g[4], g[5], g[6], g[7]};
                    asm volatile("" : "+v"(acc[ai][bj][m][0]), "+v"(acc[ai][bj][m][1])); } }
    }
    __device__ __forceinline__ void operator()(const f32x4 (&acc)[2][2][4][2], const Unit& u, int wr, int wc, int fr, int fq) const {
#pragma unroll
        for (int ai = 0; ai < 2; ++ai)
#pragma unroll
            for (int m = 0; m < 4; ++m) { const int row = EPI_ROW(ai, m);
#pragma unroll
                for (int bj = 0; bj < 2; ++bj) { const int c0 = EPI_COL(bj); float v[8], g[8]; EPI_LOAD8(v, ai, bj, m, F8_IYP);
                    unpack8(*(const u32x4*)(proj + (size_t)row * NPROJ + C_GB + c0), g);
#pragma unroll
                    for (int j = 0; j < 8; ++j) v[j] *= g[j];
                    *(u32x4*)(mrg + (size_t)row * DM + c0) = pack8(v); } }
    }
};
template <bool IN_F32>
struct EpiResid {
    static constexpr bool CONT = false;
    const void* xi; bf16_t* xb; float* ssq;
    __device__ __forceinline__ void operator()(const f32x4 (&acc)[2][2][4][2], const Unit& u, int wr, int wc, int fr, int fq) const {
#pragma unroll
        for (int ai = 0; ai < 2; ++ai)
#pragma unroll
            for (int m = 0; m < 4; ++m) { const int row = EPI_ROW(ai, m); float ss = 0.f;
#pragma unroll
                for (int bj = 0; bj < 2; ++bj) { const int c0 = EPI_COL(bj); const size_t off = (size_t)row * DM + c0; float r[8];
                    if (IN_F32) { const f32x4 r0 = *(const f32x4*)((const float*)xi + off), r1 = *(const f32x4*)((const float*)xi + off + 4); r[0] = r0[0]; r[1] = r0[1]; r[2] = r0[2]; r[3] = r0[3]; r[4] = r1[0]; r[5] = r1[1]; r[6] = r1[2]; r[7] = r1[3]; }
                    else unpack8(*(const u32x4*)((const bf16_t*)xi + off), r);
                    const f32x4 a0 = acc[ai][bj][m][0], a1 = acc[ai][bj][m][1];
                    r[0] += a0[0]; r[1] += a0[1]; r[2] += a0[2]; r[3] += a0[3]; r[4] += a1[0]; r[5] += a1[1]; r[6] += a1[2]; r[7] += a1[3];
                    ss += (r[0] * r[0] + r[1] * r[1]) + (r[2] * r[2] + r[3] * r[3]) + (r[4] * r[4] + r[5] * r[5]) + (r[6] * r[6] + r[7] * r[7]);
                    *(u32x4*)(xb + off) = pack8(r); }
                ss += __shfl_xor(ss, 16); ss += __shfl_xor(ss, 32); if (fq == 0) atomicAdd(ssq + row, ss); }
    }
};
struct EpiQx {
    static constexpr bool CONT = false;
    bf16_t* q0; bf16_t* q1; const float* ssq1;
    __device__ __forceinline__ void operator()(const f32x4 (&acc)[2][2][4][2], const Unit& u, int wr, int wc, int fr, int fq) const {
        bf16_t* q = u.kind ? q1 : q0;
#pragma unroll
        for (int ai = 0; ai < 2; ++ai)
#pragma unroll
            for (int m = 0; m < 4; ++m) { const int row = EPI_ROW(ai, m); const float rs = 0.0625f * __builtin_amdgcn_rsqf(ssq1[row] * (1.f / DM) + EPS);
#pragma unroll
                for (int bj = 0; bj < 2; ++bj) { float v[8]; EPI_LOAD8(v, ai, bj, m, rs); *(u32x4*)(q + (size_t)row * 1024 + EPI_COL(bj)) = pack8(v); } }
    }
};
struct EpiFfnUp {
    static constexpr bool CONT = false;
    bf16_t* hdn; const float* ssq2;
    __device__ __forceinline__ void operator()(const f32x4 (&acc)[2][2][4][2], const Unit& u, int wr, int wc, int fr, int fq) const {
#pragma unroll
        for (int ai = 0; ai < 2; ++ai)
#pragma unroll
            for (int m = 0; m < 4; ++m) { const int row = EPI_ROW(ai, m); const float rs = __builtin_amdgcn_rsqf(ssq2[row] * (1.f / DM) + EPS);
                float g[8], w[8]; EPI_LOAD8(g, ai, 0, m, rs); EPI_LOAD8(w, ai, 1, m, rs);
#pragma unroll
                for (int j = 0; j < 8; ++j) g[j] = g[j] * sigmoidf_(g[j]) * w[j];
                *(u32x4*)(hdn + (size_t)row * FFN + u.pn * 128 + wc * 32 + 8 * fq) = pack8(g); }
    }
};

struct SchedZa { int G, c; const char *xb, *win;
    __device__ __forceinline__ bool next(int i, Unit& u) const { const int L = i * G + c; if (L >= 672) return false; const size_t ts = (size_t)256 * DM * 2;
        pg8::tile_of(L, 32, 21, u.pm, u.pn); u.kind = 0; u.A = xb + u.pm * ts; u.B = win + u.pn * ts; return true; } };
struct SchedF8 { int G, c, skip5, extra; const char *xb8, *win8;
    __device__ __forceinline__ bool next(int i, Unit& u) const { int L = i * G + c;
        if (skip5) { if (i >= 5) return false; } else if (extra >= 0 && i == 6) L = 5 * G + extra; else if (L >= 1408) return false;
        const size_t ts = (size_t)256 * DM;
        int pn8; pg8::tile_of(L, 32, 44, u.pm, pn8); u.pn = pn8 < 12 ? 16 + pn8 : (pn8 < 28 ? 200 + (pn8 - 12) : 100 + (pn8 - 28)); u.kind = 0; u.A = xb8 + u.pm * ts; u.B = win8 + pn8 * ts; return true; } };
struct SchedKV { int G, c; const char *memb, *wk, *wv;
    __device__ __forceinline__ bool next(int i, Unit& u) const { const int j = i * G + c; if (j >= 32) return false; const size_t ts = (size_t)256 * DM * 2; const int t = j & 15;
        u.kind = 1 + (j >> 4); u.pm = t >> 2; u.pn = t & 3;
        if (u.kind == 1) { u.A = memb + u.pm * ts; u.B = wk + u.pn * ts; } else { u.A = wv + u.pm * ts; u.B = memb + u.pn * ts; } return true; } };
struct SchedOne { Unit u0;
    __device__ __forceinline__ bool next(int i, Unit& u) const { if (i) return false; u = u0; return true; } };
struct SchedSimple { int G, c, nM, nN; const char *A, *B; size_t tsA, tsB;
    __device__ __forceinline__ bool next(int i, Unit& u) const { const int L = i * G + c; if (L >= nM * nN) return false; pg8::tile_of(L, nM, nN, u.pm, u.pn); u.kind = 0;
        u.A = A + u.pm * tsA; u.B = B + u.pn * tsB; return true; } };
struct SchedG6 { int G, c; const char *x1b, *wq;
    __device__ __forceinline__ bool next(int i, Unit& u) const { const int L = i * G + c; if (L >= 256) return false; pg8::tile_of(L & 127, 32, 4, u.pm, u.pn); u.kind = L >> 7;
        const size_t ts = (size_t)256 * DM * 2; u.A = x1b + u.pm * ts + (u.kind ? 2048 * 2 : 0); u.B = wq + u.pn * ts + (u.kind ? 2048 * 2 : 0); return true; } };

#ifndef CVT_KTB
#define CVT_KTB 128
#endif
#ifndef CVT_KT8
#define CVT_KT8 256
#endif
constexpr int KTB = CVT_KTB, KT8 = CVT_KT8, CVT_SCR = 17408;
template <bool NT_ST, class Src>
__device__ __forceinline__ void cvt_tile(const float* __restrict__ W, int K, int N, const float* __restrict__ gain, bf16_t* __restrict__ WT, LAS unsigned char* scr, int k0, int n0, int lane, Src src) {
    constexpr int PITCH = KTB * 2 + 16, LPR = KTB / 8;
    const int g = lane >> 4, c = lane & 15, sc = src(n0 + 4 * c);
#pragma unroll
    for (int p = 0; p < KTB / 64; ++p) { const int kk = k0 + 64 * p;
        f32x4 v[16];
        if (sc >= 0) { const float* wp = W + (size_t)(kk + 16 * g) * N + sc;
#pragma unroll
            for (int i = 0; i < 16; ++i) v[i] = __builtin_nontemporal_load((const f32x4*)(wp + (size_t)i * N)); }
        else {
#pragma unroll
            for (int i = 0; i < 16; ++i) v[i] = (f32x4){0.f, 0.f, 0.f, 0.f}; }
        if (gain) {
#pragma unroll
            for (int q = 0; q < 4; ++q) { const f32x4 gq = *(const f32x4*)(gain + kk + 16 * g + 4 * q); v[4 * q] *= gq[0]; v[4 * q + 1] *= gq[1]; v[4 * q + 2] *= gq[2]; v[4 * q + 3] *= gq[3]; } }
#pragma unroll
        for (int j = 0; j < 4; ++j) { u32x4 a, b2;
            a.x = pk2(v[0][j], v[1][j]); a.y = pk2(v[2][j], v[3][j]); a.z = pk2(v[4][j], v[5][j]); a.w = pk2(v[6][j], v[7][j]);
            b2.x = pk2(v[8][j], v[9][j]); b2.y = pk2(v[10][j], v[11][j]); b2.z = pk2(v[12][j], v[13][j]); b2.w = pk2(v[14][j], v[15][j]);
            LAS unsigned char* sp = scr + (4 * c + j) * PITCH + 128 * p + 32 * g; *(LAS u32x4*)sp = a; *(LAS u32x4*)(sp + 16) = b2; } }
    LDS_WAIT(); asm volatile("" ::: "memory");
#pragma unroll
    for (int r = 0; r < LPR; ++r) { const int row = (64 / LPR) * r + lane / LPR, ch = lane % LPR; const u32x4 o = *(const LAS u32x4*)(scr + row * PITCH + 16 * ch);
        u32x4* dp = (u32x4*)(WT + (size_t)(n0 + row) * K + k0 + 8 * ch); if (NT_ST) __builtin_nontemporal_store(o, dp); else *dp = o; }
    LDS_WAIT(); asm volatile("" ::: "memory");
}
template <class Src>
__device__ __forceinline__ void cvt_tile8(const float* __restrict__ W, int K, int N, const float* __restrict__ gain, float scale, unsigned char* __restrict__ WT8, LAS unsigned char* scr, int k0, int n0, int n0dst, int lane, Src src) {
    constexpr int PITCH = KT8 + 16, LPR = KT8 / 16;
    const int g = lane >> 4, c = lane & 15, sc = src(n0 + 4 * c);
#pragma unroll
    for (int p = 0; p < KT8 / 64; ++p) { const int kk = k0 + 64 * p;
        f32x4 v[16];
        if (sc >= 0) { const float* wp = W + (size_t)(kk + 16 * g) * N + sc;
#pragma unroll
            for (int i = 0; i < 16; ++i) v[i] = __builtin_nontemporal_load((const f32x4*)(wp + (size_t)i * N)); }
        else {
#pragma unroll
            for (int i = 0; i < 16; ++i) v[i] = (f32x4){0.f, 0.f, 0.f, 0.f}; }
#pragma unroll
        for (int q = 0; q < 4; ++q) { f32x4 gq = gain ? *(const f32x4*)(gain + kk + 16 * g + 4 * q) : (f32x4){1.f, 1.f, 1.f, 1.f}; gq *= scale; v[4 * q] *= gq[0]; v[4 * q + 1] *= gq[1]; v[4 * q + 2] *= gq[2]; v[4 * q + 3] *= gq[3]; }
#pragma unroll
        for (int j = 0; j < 4; ++j) { u32x4 a;
            a.x = pk4_fp8(v[0][j], v[1][j], v[2][j], v[3][j]); a.y = pk4_fp8(v[4][j], v[5][j], v[6][j], v[7][j]); a.z = pk4_fp8(v[8][j], v[9][j], v[10][j], v[11][j]); a.w = pk4_fp8(v[12][j], v[13][j], v[14][j], v[15][j]);
            *(LAS u32x4*)(scr + (4 * c + j) * PITCH + 64 * p + 16 * g) = a; } }
    LDS_WAIT(); asm volatile("" ::: "memory");
#pragma unroll
    for (int r = 0; r < LPR; ++r) { const int row = (64 / LPR) * r + lane / LPR, ch = lane % LPR; const u32x4 o = *(const LAS u32x4*)(scr + row * PITCH + 16 * ch);
        *(u32x4*)(WT8 + (size_t)(n0dst + row) * K + k0 + 16 * ch) = o; }
    LDS_WAIT(); asm volatile("" ::: "memory");
}
struct SrcId { static constexpr bool NTL = true; __device__ __forceinline__ int operator()(int n) const { return n; } };
struct SrcId0 { static constexpr bool NTL = false; __device__ __forceinline__ int operator()(int n) const { return n; } };
struct SrcWinB { static constexpr bool NTL = false; __device__ __forceinline__ int operator()(int n) const { if (n < 4096) return n; if (n < 5200) return 7168 + (n - 4096); return -1; } };
struct SrcWin8 { static constexpr bool NTL = false; __device__ __forceinline__ int operator()(int n) const { return n < 3072 ? 4096 + n : 8272 + (n - 3072); } };
struct Src13 { static constexpr bool NTL = true; __device__ __forceinline__ int operator()(int n) const { return (n >> 8) * 128 + (n & 127); } };
__device__ __forceinline__ void row_to_bf16(const float* xrow, bf16_t* orow, unsigned* o8row, float* rstd, int lane) {
    const f32x4* xr = (const f32x4*)xrow + lane; float s = 0.f; f32x4 v[16];
#pragma unroll
    for (int j = 0; j < 16; ++j) { v[j] = xr[64 * j]; s += (v[j][0] * v[j][0] + v[j][1] * v[j][1]) + (v[j][2] * v[j][2] + v[j][3] * v[j][3]); }
    s = wave_sum(s);
    if (lane == 0) *rstd = 1.0f / sqrtf(s * (1.f / DM) + EPS);
    u32x2* o8 = (u32x2*)orow + lane;
#pragma unroll
    for (int j = 0; j < 16; ++j) { u32x2 w; w.x = pk2(v[j][0], v[j][1]); w.y = pk2(v[j][2], v[j][3]); o8[64 * j] = w; }
    if (o8row) {
#pragma unroll
        for (int j = 0; j < 16; ++j) o8row[64 * j + lane] = pk4_fp8(v[j][0] * F8_SA, v[j][1] * F8_SA, v[j][2] * F8_SA, v[j][3] * F8_SA); }
}
struct CvtItem { const float* wp; const float* gp; unsigned char* dst; int N, K; float scale; int f8, nts; };
constexpr int CW_BUF = 69632, CW_PB = 272, CW_P8 = 144;
template <class Src>
__device__ __forceinline__ void cw_fill(CvtItem& it, const float* W, int K, int N, const float* gain, float scale, unsigned char* dst, int eb, int kb, int nb, int wave, int lane, Src src) {
    const int k0 = kb * 128, n0 = nb * 256, sc = src(n0 + 4 * lane);
    it.wp = sc >= 0 ? W + (size_t)(k0 + 16 * wave) * N + sc : nullptr; it.gp = gain ? gain + k0 + 16 * wave : nullptr; it.dst = dst + ((size_t)n0 * K + k0) * eb; it.N = N; it.K = K; it.scale = scale; it.f8 = (eb == 1); it.nts = Src::NTL;
}
__device__ __forceinline__ void cw_load(const CvtItem& it, f32x4 (&v)[16]) {
    if (it.wp) {
#pragma unroll
        for (int i = 0; i < 16; ++i) v[i] = __builtin_nontemporal_load((const f32x4*)(it.wp + (size_t)i * it.N)); }
    else {
#pragma unroll
        for (int i = 0; i < 16; ++i) v[i] = (f32x4){0.f, 0.f, 0.f, 0.f}; }
}
__device__ __forceinline__ void cw_to_lds(const CvtItem& it, f32x4 (&v)[16], LAS unsigned char* buf, int wave, int lane) {
#pragma unroll
    for (int i = 0; i < 16; ++i) { const float g = (it.gp ? it.gp[i] : 1.f) * it.scale; v[i] *= g; }
    if (it.f8) {
#pragma unroll
        for (int j = 0; j < 4; ++j) { u32x4 a;
            a.x = pk4_fp8(v[0][j], v[1][j], v[2][j], v[3][j]); a.y = pk4_fp8(v[4][j], v[5][j], v[6][j], v[7][j]); a.z = pk4_fp8(v[8][j], v[9][j], v[10][j], v[11][j]); a.w = pk4_fp8(v[12][j], v[13][j], v[14][j], v[15][j]);
            *(LAS u32x4*)(buf + (4 * lane + j) * CW_P8 + 16 * wave) = a; } }
    else {
#pragma unroll
        for (int j = 0; j < 4; ++j) { u32x4 a, b2;
            a.x = pk2(v[0][j], v[1][j]); a.y = pk2(v[2][j], v[3][j]); a.z = pk2(v[4][j], v[5][j]); a.w = pk2(v[6][j], v[7][j]);
            b2.x = pk2(v[8][j], v[9][j]); b2.y = pk2(v[10][j], v[11][j]); b2.z = pk2(v[12][j], v[13][j]); b2.w = pk2(v[14][j], v[15][j]);
            LAS unsigned char* sp = buf + (4 * lane + j) * CW_PB + 32 * wave; *(LAS u32x4*)sp = a; *(LAS u32x4*)(sp + 16) = b2; } }
}
__device__ __forceinline__ void cw_store(const CvtItem& it, LAS unsigned char* buf, int tid) {
    if (it.f8) {
#pragma unroll
        for (int rr = 0; rr < 4; ++rr) { const int row = 64 * rr + (tid >> 3), ch = tid & 7; const u32x4 o = *(const LAS u32x4*)(buf + row * CW_P8 + 16 * ch);
            u32x4* dp = (u32x4*)(it.dst + (size_t)row * it.K + 16 * ch); if (it.nts) __builtin_nontemporal_store(o, dp); else *dp = o; } }
    else {
#pragma unroll
        for (int rr = 0; rr < 8; ++rr) { const int row = 32 * rr + (tid >> 4), ch = tid & 15; const u32x4 o = *(const LAS u32x4*)(buf + row * CW_PB + 16 * ch);
            u32x4* dp = (u32x4*)(it.dst + (size_t)row * it.K * 2 + 16 * ch); if (it.nts) __builtin_nontemporal_store(o, dp); else *dp = o; } }
}
template <class Get>
__device__ __forceinline__ void cw_run(Frame& F, int first, int step, int end, Get get) {
    if (first >= end) return;
    int tz = F.tid; asm volatile("" : "+v"(tz));
    const int wave = F.wave, lane = tz & 63;
    CvtItem c0, c1, st; f32x4 v0[16], v1[16];
    get(first, wave, lane, c0); cw_load(c0, v0); c1 = c0;
    if (first + step < end) { get(first + step, wave, lane, c1); cw_load(c1, v1); }
    __syncthreads();
    for (int r = first; r < end; r += 2 * step) {
        cw_to_lds(c0, v0, F.lds, wave, lane); st = c0;
        if (r + 2 * step < end) { get(r + 2 * step, wave, lane, c0); cw_load(c0, v0); }
        __syncthreads();
        cw_store(st, F.lds, tz);
        if (r + step >= end) break;
        cw_to_lds(c1, v1, F.lds + CW_BUF, wave, lane); st = c1;
        if (r + 3 * step < end) { get(r + 3 * step, wave, lane, c1); cw_load(c1, v1); }
        __syncthreads();
        cw_store(st, F.lds + CW_BUF, tz);
    }
    __syncthreads();
}
constexpr int CW_WINB = 32 * 21, CW_WIN8 = 32 * 44, CW_XQ = 32 * 4, CW_XO = 8 * 16, CW_N0 = CW_WINB + CW_WIN8 + 3 * CW_XQ + CW_XO;
constexpr int CW_WOUT = 32 * 16, CW_PB8 = 16 * 16, CW_PA = 16 * 16, CW_W2 = (FFN / 128) * 16, CW_W13 = 32 * (N13 / 256), CW_NL = CW_WOUT + CW_PB8 + CW_PA + CW_W2 + CW_W13;
__device__ __forceinline__ void cw_item_p0(const Params& P, unsigned char* ws, int r, int wave, int lane, CvtItem& it) {
    if (r < CW_WINB) { cw_fill(it, P.w_in, DM, 16464, P.norm_mix_g, 1.f, ws + WS_WIN, 2, r / 21, r % 21, wave, lane, SrcWinB()); return; } r -= CW_WINB;
    if (r < CW_WIN8) { cw_fill(it, P.w_in, DM, 16464, P.norm_mix_g, F8_SB, ws + WS_WIN8, 1, r / 44, r % 44, wave, lane, SrcWin8()); return; } r -= CW_WIN8;
    if (r < CW_XQ) { cw_fill(it, P.xq, DM, 1024, P.norm_x_g, 1.f, ws + WS_WQ, 2, r / 4, r % 4, wave, lane, SrcId()); return; } r -= CW_XQ;
    if (r < CW_XQ) { cw_fill(it, P.xk, DM, 1024, P.norm_mem_g, 1.f, ws + WS_WK, 2, r / 4, r % 4, wave, lane, SrcId0()); return; } r -= CW_XQ;
    if (r < CW_XQ) { cw_fill(it, P.xv, DM, 1024, P.norm_mem_g, 1.f, ws + WS_WV, 2, r / 4, r % 4, wave, lane, SrcId0()); return; } r -= CW_XQ;
    cw_fill(it, P.xo, 1024, DM, nullptr, 1.f, ws + WS_WO, 2, r / 16, r % 16, wave, lane, SrcId());
}
__device__ __forceinline__ void cw_item_late(const Params& P, unsigned char* ws, int r, int wave, int lane, CvtItem& it) {
    if (r < CW_WOUT) { cw_fill(it, P.w_out, DM, DM, nullptr, 1.f, ws + WS_WOUT, 2, r / 16, r % 16, wave, lane, SrcId()); return; } r -= CW_WOUT;
    if (r < CW_PB8) { cw_fill(it, P.p_b, 2048, DM, nullptr, F8_SPB, ws + WS_PB, 1, r / 16, r % 16, wave, lane, SrcId()); return; } r -= CW_PB8;
    if (r < CW_PA) { cw_fill(it, P.p_a, 2048, DM, nullptr, 1.f, ws + WS_PA, 2, r / 16, r % 16, wave, lane, SrcId()); return; } r -= CW_PA;
    if (r < CW_W2) { cw_fill(it, P.w2, FFN, DM, nullptr, 1.f, ws + WS_W2, 2, r / 16, r % 16, wave, lane, SrcId()); return; } r -= CW_W2;
    { const int nb = r % (N13 / 256); const float* W = (((nb * 256 + 4 * lane) >> 7) & 1) ? P.w3 : P.w1; cw_fill(it, W, DM, FFN, P.norm_ffn_g, 1.f, ws + WS_W13, 2, r / (N13 / 256), nb, wave, lane, Src13()); }
}
#ifndef N_FREE_WG
#define N_FREE_WG 40
#endif
#ifndef P0_MID
#define P0_MID 0
#endif
#ifndef P0_W2_PCT
#define P0_W2_PCT 0
#endif
constexpr int I_WINB = (DM / KTB) * 84, I_WIN8 = (DM / KT8) * 176, I_PB = (2048 / KT8) * 64, I_PA = (2048 / KTB) * 64, I_WOUT = (DM / KTB) * 64, I_XQ = (DM / KTB) * 16, I_XO = (1024 / KTB) * 64, I_2 = (FFN / KTB) * 64, I_13 = (DM / KTB) * (N13 / 64);
constexpr int N_MIDLATE = I_PB + I_PA + I_WOUT + I_2 + I_13;
constexpr int N_MID_EARLY = P0_MID * (I_PB + I_PA + I_WOUT) + (I_2 * P0_W2_PCT) / 100;
__device__ __forceinline__ void midlate_item(const Params& P, unsigned char* ws, LAS unsigned char* scr, int r, int lane) {
    if (r < I_WOUT) { cvt_tile<true>(P.w_out, DM, DM, nullptr, (bf16_t*)(ws + WS_WOUT), scr, KTB * (r / 64), 64 * (r % 64), lane, SrcId()); return; } r -= I_WOUT;
    if (r < I_PB) { cvt_tile8(P.p_b, 2048, DM, nullptr, F8_SPB, ws + WS_PB, scr, KT8 * (r / 64), 64 * (r % 64), 64 * (r % 64), lane, SrcId()); return; } r -= I_PB;
    if (r < I_PA) { cvt_tile<true>(P.p_a, 2048, DM, nullptr, (bf16_t*)(ws + WS_PA), scr, KTB * (r / 64), 64 * (r % 64), lane, SrcId()); return; } r -= I_PA;
    if (r < I_2) { cvt_tile<true>(P.w2, FFN, DM, nullptr, (bf16_t*)(ws + WS_W2), scr, KTB * (r / 64), 64 * (r % 64), lane, SrcId()); return; } r -= I_2;
    { const int nb = N13 / 64, n0 = 64 * (r % nb); cvt_tile<true>(((n0 >> 7) & 1) ? P.w3 : P.w1, DM, FFN, P.norm_ffn_g, (bf16_t*)(ws + WS_W13), scr, KTB * (r / nb), n0, lane, Src13()); }
}
__device__ __forceinline__ void p0_prologue(Frame& F, const Params& P, const bool with_late) {
    LAS unsigned char* scr = F.lds + F.wave * CVT_SCR;
    const int gw = F.bid * 8 + F.wave, NGW = F.G * 8, lane = F.lane;
    unsigned char* ws = F.ws;
    cw_run(F, F.bid, F.G, CW_N0, [&](int r, int wv, int ln, CvtItem& it) { cw_item_p0(P, ws, r, wv, ln, it); });
    if (with_late) cw_run(F, F.bid, F.G, CW_NL, [&](int r, int wv, int ln, CvtItem& it) { cw_item_late(P, ws, r, wv, ln, it); });
    for (int m = gw; m < M; m += NGW) row_to_bf16(P.x + (size_t)m * DM, (bf16_t*)(ws + WS_XB) + (size_t)m * DM, (unsigned*)(ws + WS_XB8) + (size_t)m * (DM / 4), F_RSTDX + m, lane);
    for (int m = gw; m < MEMR; m += NGW) row_to_bf16(P.mem + (size_t)m * DM, (bf16_t*)(ws + WS_MEMB) + (size_t)m * DM, nullptr, F_RSTDM + m, lane);
    const int gt = F.bid * 512 + F.tid, NGT = F.G * 512;
    for (int e = gt; e < M * 24; e += NGT) { const int row = e / 24, i = e % 24; const bool isb = i < 16; const int fi = isb ? i : i - 16;
        const float inv = powf(500000.0f, isb ? -(float)fi / 16.0f : -(float)fi / 8.0f); const float ang = (float)P.pos[row] * inv;
        const double tr = (double)ang * 0.15915494309189535; const float fr = (float)(tr - rint(tr));
        const float cv = __builtin_amdgcn_cosf(fr), sv = __builtin_amdgcn_sinf(fr);
        if (isb) { F_ROPEB[(size_t)row * 32 + fi] = cv; F_ROPEB[(size_t)row * 32 + 16 + fi] = sv; } else { F_ROPEI[(size_t)row * 16 + fi] = cv; F_ROPEI[(size_t)row * 16 + 8 + fi] = sv; } }
    bf16_t* Wc = (bf16_t*)(ws + WS_WC);
    for (int e = gt; e < 16 * 128 * 128; e += NGT) { const int s = e & 127, t = (e >> 7) & 127; Wc[e] = (s <= t) ? (bf16_t)(pk2(P.a_sw[e], 0.f) & 0xffffu) : (bf16_t)0; }
}

__device__ __forceinline__ void convert_late(Frame& F, const Params& P, unsigned* ctr) {
    LAS unsigned char* scr = F.lds + F.wave * CVT_SCR;
    for (;;) {
        unsigned r = 0; if (F.lane == 0) r = atomicAdd(ctr, 1u);
        r = (unsigned)__builtin_amdgcn_readfirstlane((int)r) + (unsigned)N_MID_EARLY;
        if (r >= (unsigned)N_MIDLATE) break;
        midlate_item(P, F.ws, scr, (int)r, F.lane);
    }
}

__device__ __forceinline__ void spatial_unit(Frame& F, const Params& P, int unit) {
    const int g = unit & 15, c = (unit >> 4) & 15, b = unit >> 8, row0 = b * SEQ + c * 128;
    int tz = F.tid; asm volatile("" : "+v"(tz));
    const int wt = F.wave >> 1, wd = F.wave & 1, fr = tz & 15, fq = (tz & 63) >> 4;
    const bf16_t* Wc = (const bf16_t*)(F.ws + WS_WC) + (size_t)g * 128 * 128;
    const bf16_t* vTa = (const bf16_t*)(F.ws + WS_VTA) + ((size_t)(b * 2048 + g * 128 + 64 * wd + fr)) * 2048 + c * 128 + 8 * fq;
    f32x4 acc[2][4];
#pragma unroll
    for (int i = 0; i < 2; ++i)
#pragma unroll
        for (int j = 0; j < 4; ++j) acc[i][j] = (f32x4){0.f, 0.f, 0.f, 0.f};
    u32x2 uw[2][4]; f32x4 gn[4]; float bias[2];
#pragma unroll
    for (int j = 0; j < 4; ++j) gn[j] = *(const f32x4*)(P.a_norm_g + g * 128 + 64 * wd + 16 * j + 4 * fq);
#pragma unroll
    for (int i = 0; i < 2; ++i) { const int t = 32 * wt + 16 * i + fr; bias[i] = P.a_sb[g * 128 + t];
#pragma unroll
        for (int j = 0; j < 4; ++j) uw[i][j] = *(const u32x2*)(F_PROJ + (size_t)(row0 + t) * NPROJ + C_U + g * 128 + 64 * wd + 16 * j + 4 * fq); }
#pragma unroll
    for (int ks = 0; ks < 4; ++ks) {
        if (ks <= wt) {
            const f32x4 q0 = *(const f32x4*)(F_SSQV + row0 + 32 * ks + 8 * fq), q1 = *(const f32x4*)(F_SSQV + row0 + 32 * ks + 8 * fq + 4);
            float rs[8];
#pragma unroll
            for (int e = 0; e < 4; ++e) { rs[e] = __builtin_amdgcn_rsqf(q0[e] * (1.f / 2048.f) + EPS); rs[4 + e] = __builtin_amdgcn_rsqf(q1[e] * (1.f / 2048.f) + EPS); }
            bf16x8 af[2], bg[4];
#pragma unroll
            for (int i = 0; i < 2; ++i) { float wv[8]; unpack8(*(const u32x4*)(Wc + (32 * wt + 16 * i + fr) * 128 + 32 * ks + 8 * fq), wv);
#pragma unroll
                for (int e = 0; e < 8; ++e) wv[e] *= rs[e];
                af[i] = __builtin_bit_cast(bf16x8, pack8(wv)); }
#pragma unroll
            for (int j = 0; j < 4; ++j) bg[j] = *(const bf16x8*)(vTa + (size_t)(16 * j) * 2048 + 32 * ks);
#pragma unroll
            for (int i = 0; i < 2; ++i)
#pragma unroll
                for (int j = 0; j < 4; ++j) acc[i][j] = MFMA16(bg[j], af[i], acc[i][j]);
        }
    }
    bf16_t* Y = F_Y;
#pragma unroll
    for (int i = 0; i < 2; ++i) { const int t = 32 * wt + 16 * i + fr; const float bs = bias[i];
        u32x2 o[4];
#pragma unroll
        for (int j = 0; j < 4; ++j) { const f32x4 gj = gn[j]; const u32x2 uu = uw[i][j];
            const float y0 = bf_lo(uu.x) * (acc[i][j][0] * gj[0] + bs), y1 = bf_hi(uu.x) * (acc[i][j][1] * gj[1] + bs), y2 = bf_lo(uu.y) * (acc[i][j][2] * gj[2] + bs), y3 = bf_hi(uu.y) * (acc[i][j][3] * gj[3] + bs);
            o[j].x = pk2(y0, y1); o[j].y = pk2(y2, y3); }
#pragma unroll
        for (int j = 0; j < 4; j += 2) { const auto rx = __builtin_amdgcn_permlane16_swap(o[j].x, o[j + 1].x, false, false); const auto ry = __builtin_amdgcn_permlane16_swap(o[j].y, o[j + 1].y, false, false);
            const int d = 64 * wd + ((fq & 1) ? 16 * (j + 1) + 4 * (fq - 1) : 16 * j + 4 * fq);
            *(u32x4*)(Y + (size_t)(row0 + t) * DM + g * 128 + d) = (u32x4){rx[0], ry[0], rx[1], ry[1]}; } }
}

__device__ __forceinline__ int wave_isum_dpp(int v) {
    v += __builtin_amdgcn_update_dpp(0, v, 0x111, 0xf, 0xf, true);
    v += __builtin_amdgcn_update_dpp(0, v, 0x112, 0xf, 0xf, true);
    v += __builtin_amdgcn_update_dpp(0, v, 0x114, 0xf, 0xf, true);
    v += __builtin_amdgcn_update_dpp(0, v, 0x118, 0xf, 0xf, true);
    v += __builtin_amdgcn_update_dpp(0, v, 0x142, 0xa, 0xf, false);
    v += __builtin_amdgcn_update_dpp(0, v, 0x143, 0xc, 0xf, false);
    return __builtin_amdgcn_readlane(v, 63);
}
__device__ __forceinline__ void transpose32(unsigned (&a)[32]) {
#pragma unroll
    for (int k = 0; k < 16; ++k) { const unsigned x = a[k], y = a[k + 16]; a[k] = __builtin_amdgcn_perm(y, x, 0x05040100u); a[k + 16] = __builtin_amdgcn_perm(y, x, 0x07060302u); }
#pragma unroll
    for (int k = 0; k < 32; ++k) if (!(k & 8)) { const unsigned x = a[k], y = a[k + 8]; a[k] = __builtin_amdgcn_perm(y, x, 0x06020400u); a[k + 8] = __builtin_amdgcn_perm(y, x, 0x07030501u); }
#pragma unroll
    for (int j = 4; j; j >>= 1) { const unsigned m = j == 4 ? 0x0f0f0f0fu : (j == 2 ? 0x33333333u : 0x55555555u);
#pragma unroll
        for (int k = 0; k < 32; ++k) if (!(k & j)) { const unsigned x = a[k], y = a[k + j]; a[k] = (x & m) | ((y << j) & ~m); a[k + j] = ((x >> j) & m) | (y & ~m); } }
}
__device__ __forceinline__ void sel_planes(const LAS float* sr, int t, int lane, unsigned (&pl)[32]) {
#pragma unroll
    for (int j = 0; j < 32; ++j) { const unsigned bits = __float_as_uint(sr[j]); const unsigned ord = bits ^ ((bits >> 31) ? 0xffffffffu : 0x80000000u); pl[j] = (32 * lane + j <= t) ? ord : 0u; }
    transpose32(pl);
}
__device__ __forceinline__ unsigned sel_finish(unsigned gt, unsigned eq, int need, int ceq, int lane) {
    if (ceq == need) return gt | eq;
    const int myeq = __builtin_popcount(eq); int inc = myeq;
#pragma unroll
    for (int o = 1; o < 64; o <<= 1) { const int v = __shfl_up(inc, o); if (lane >= o) inc += v; }
    int take = need - (inc - myeq); take = take < 0 ? 0 : (take > myeq ? myeq : take);
    unsigned kept = 0u, e = eq; while (take > 0) { const unsigned lo = e & (0u - e); kept |= lo; e ^= lo; --take; }
    return gt | kept;
}
__device__ __forceinline__ void indexer_unit(Frame& F, int b, int tile) {
    int tz = F.tid; asm volatile("" : "+v"(tz));
    const int tok0 = tile * 16, w = F.wave, lane = tz & 63, r = lane & 31, h = lane >> 5;
    LAS float* sc = (LAS float*)F.lds;
    const int tk = tok0 + 2 * w + ((r >> 2) & 1), hd = (r & 3) + 4 * (r >> 3);
    const bf16_t* ap = F_PROJ + (size_t)(b * SEQ + tk) * NPROJ + C_QI + hd * 64 + 8 * h;
    bf16x8 af[4];
#pragma unroll
    for (int s = 0; s < 4; ++s) af[s] = *(const bf16x8*)(ap + 16 * s);
    float wv[16];
    { const bf16_t* wp = F_PROJ + (size_t)(b * SEQ + tok0 + 2 * w + h) * NPROJ + C_WI; float t0[8], t1[8]; unpack8(*(const u32x4*)wp, t0); unpack8(*(const u32x4*)(wp + 8), t1);
#pragma unroll
      for (int j = 0; j < 8; ++j) { wv[j] = t0[j]; wv[8 + j] = t1[j]; } }
    const int nkt = (tok0 + 15) / 32 + 1;
    __syncthreads();
    const bf16_t* kp = F_PROJ + (size_t)(b * SEQ + r) * NPROJ + C_KI + 8 * h;
    bf16x8 kf[4][4];
#pragma unroll
    for (int i = 0; i < 4; ++i) { const bf16_t* kq = kp + (size_t)(i < nkt ? i : nkt - 1) * 32 * NPROJ;
#pragma unroll
        for (int s = 0; s < 4; ++s) kf[i][s] = *(const bf16x8*)(kq + 16 * s); }
    for (int kt = 0; kt < nkt; kt += 4) {
#pragma unroll
        for (int i = 0; i < 4; ++i) {
            if (kt + i < nkt) {
                f32x16 acc;
#pragma unroll
                for (int q = 0; q < 16; ++q) acc[q] = 0.f;
#pragma unroll
                for (int s = 0; s < 4; ++s) acc = MFMA32(af[s], kf[i][s], acc);
                float sco = 0.f;
#pragma unroll
                for (int q = 0; q < 16; ++q) sco += wv[q] * fmaxf(acc[q], 0.f);
                const int key = (kt + i) * 32 + r;
                sc[(2 * w + h) * 2112 + key + (key >> 5)] = sco;
            }
            { const int kn = kt + i + 4; const bf16_t* kq = kp + (size_t)(kn < nkt ? kn : nkt - 1) * 32 * NPROJ;
#pragma unroll
              for (int s = 0; s < 4; ++s) kf[i][s] = *(const bf16x8*)(kq + 16 * s); }
        }
    }
    LDS_WAIT(); asm volatile("" ::: "memory");
    {
        const int tA = tok0 + 2 * w;
        unsigned* mrow = F_MASK + (size_t)(b * SEQ + tA) * 64;
        unsigned wordA, wordB;
        if (tA < 256) {
            const int nA = tA + 1 - 32 * lane, nB = nA + 1;
            wordA = nA >= 32 ? 0xffffffffu : (nA <= 0 ? 0u : ((1u << nA) - 1u)); wordB = nB >= 32 ? 0xffffffffu : (nB <= 0 ? 0u : ((1u << nB) - 1u));
        } else {
            unsigned pa[32], pb[32];
            sel_planes(sc + (2 * w) * 2112 + 33 * lane, tA, lane, pa); sel_planes(sc + (2 * w + 1) * 2112 + 33 * lane, tA + 1, lane, pb);
            unsigned alA = 0xffffffffu, alB = 0xffffffffu, gtA = 0u, gtB = 0u; int abA = 0, abB = 0; bool dA = false, dB = false;
#pragma unroll
            for (int bit = 31; bit >= 0; --bit) {
                if (dA && dB) break;
                const unsigned mA = alA & pa[bit], mB = alB & pb[bit];
                const int tot = wave_isum_dpp(__builtin_popcount(mA) | (__builtin_popcount(mB) << 16));
                const int cA = tot & 0xffff, cB = tot >> 16;
                if (!dA) { if (abA + cA >= 256) { alA = mA; dA = (abA + cA == 256); } else { abA += cA; gtA |= mA; alA &= ~pa[bit]; } }
                if (!dB) { if (abB + cB >= 256) { alB = mB; dB = (abB + cB == 256); } else { abB += cB; gtB |= mB; alB &= ~pb[bit]; } }
            }
            const int tote = wave_isum_dpp(__builtin_popcount(alA) | (__builtin_popcount(alB) << 16));
            wordA = sel_finish(gtA, alA, 256 - abA, tote & 0xffff, lane); wordB = sel_finish(gtB, alB, 256 - abB, tote >> 16, lane);
        }
        mrow[lane] = wordA; mrow[64 + lane] = wordB;
    }
}
__device__ __forceinline__ void attn_unit(Frame& F, int b, int kvh, int qt) {
    constexpr int KP = 272, VP = 144, BUF = 64 * KP + 128 * VP;
    LAS unsigned* mk = (LAS unsigned*)(F.lds + 2 * BUF);
    int tz = F.tid; asm volatile("" : "+v"(tz));
    const int T0 = qt * 64, w = F.wave, lane = tz & 63, q = lane & 31, h = lane >> 5, tg = w >> 2, hq = kvh * 4 + (w & 3);
    const size_t rowq = (size_t)(b * SEQ + T0 + 32 * tg + q);
    bf16x8 qf[8];
    { const bf16_t* qp = F_PROJ + rowq * NPROJ + C_Q + hq * 128 + 8 * h;
#pragma unroll
      for (int ds = 0; ds < 8; ++ds) qf[ds] = *(const bf16x8*)(qp + 16 * ds); }
    const bf16_t* kg = F_PROJ + (size_t)(b * SEQ + (tz >> 4)) * NPROJ + C_K + kvh * 128 + (tz & 15) * 8;
    const bf16_t* vg = F_VT + (size_t)(b * 512 + kvh * 128 + (tz >> 3)) * 2048 + (tz & 7) * 8;
    const int kl = (tz >> 4) * KP + (tz & 15) * 16, vl = 64 * KP + (tz >> 3) * VP + ((tz & 7) >> 1) * 32 + (tz & 1) * 8;
    u32x4 pk0, pk1, pv0, pv1;
    pk0 = *(const u32x4*)kg; pk1 = *(const u32x4*)(kg + (size_t)32 * NPROJ); pv0 = *(const u32x4*)vg; pv1 = *(const u32x4*)(vg + (size_t)64 * 2048);
    __syncthreads();
    for (int i = tz; i < 64 * 64; i += 512) { const int rr = i >> 6, cc = i & 63; mk[rr * 65 + cc] = F_MASK[(size_t)(b * SEQ + T0 + rr) * 64 + cc]; }
    *(LAS u32x4*)(F.lds + kl) = pk0; *(LAS u32x4*)(F.lds + kl + 32 * KP) = pk1; *(LAS u32x2*)(F.lds + vl) = (u32x2){pv0.x, pv0.y}; *(LAS u32x2*)(F.lds + vl + 16) = (u32x2){pv0.z, pv0.w}; *(LAS u32x2*)(F.lds + vl + 64 * VP) = (u32x2){pv1.x, pv1.y}; *(LAS u32x2*)(F.lds + vl + 64 * VP + 16) = (u32x2){pv1.z, pv1.w};
    __syncthreads();
    f32x16 o[4];
#pragma unroll
    for (int dt = 0; dt < 4; ++dt)
#pragma unroll
        for (int i = 0; i < 16; ++i) o[dt][i] = 0.f;
    const float NEG = -1.0e30f, cl = 0.08838834764831845f * 1.4426950408889634f;
    float mrun = NEG, lrun = 0.f;
    const int nkt = qt + 1;
    for (int kt = 0; kt < nkt; ++kt) {
        LAS unsigned char* ldsK = F.lds + (kt & 1) * BUF; LAS unsigned char* ldsV = ldsK + 64 * KP;
        const bool more = kt + 1 < nkt;
        if (more) { const bf16_t* kn = kg + (size_t)(kt + 1) * 64 * NPROJ; const bf16_t* vn = vg + (kt + 1) * 64;
            pk0 = *(const u32x4*)kn; pk1 = *(const u32x4*)(kn + (size_t)32 * NPROJ); pv0 = *(const u32x4*)vn; pv1 = *(const u32x4*)(vn + (size_t)64 * 2048); }
#pragma unroll
        for (int hf = 0; hf < 2; ++hf) {
            f32x16 sv;
#pragma unroll
            for (int i = 0; i < 16; ++i) sv[i] = 0.f;
#pragma unroll
            for (int ds = 0; ds < 8; ++ds) { const bf16x8 kf = *(const LAS bf16x8*)(ldsK + (q + 32 * hf) * KP + (16 * ds + 8 * h) * 2); sv = MFMA32(kf, qf[ds], sv); }
            const unsigned wm = mk[(32 * tg + q) * 65 + 2 * kt + hf] >> (4 * h);
            float tmax = NEG;
#pragma unroll
            for (int i = 0; i < 16; ++i) { const int pos = (i & 3) + 8 * (i >> 2); const int sel = __builtin_amdgcn_sbfe((int)wm, pos, 1); sv[i] = __int_as_float((sel & __float_as_int(sv[i])) | (~sel & __float_as_int(NEG))); tmax = fmaxf(tmax, sv[i]); }
            tmax = xmax32(tmax);
            if (!__all((tmax - mrun) * cl <= 8.0f)) {
                const float mnew = fmaxf(mrun, tmax), alpha = __builtin_amdgcn_exp2f((mrun - mnew) * cl); mrun = mnew; lrun *= alpha;
#pragma unroll
                for (int dt = 0; dt < 4; ++dt)
#pragma unroll
                    for (int i = 0; i < 16; ++i) o[dt][i] *= alpha; }
            const float mc = mrun * cl;
            float ps = 0.f;
#pragma unroll
            for (int i = 0; i < 16; ++i) { sv[i] = __builtin_amdgcn_exp2f(sv[i] * cl - mc); ps += sv[i]; }
            lrun += ps;
            bf16x8 pf[2];
#pragma unroll
            for (int s2 = 0; s2 < 2; ++s2) { u32x4 a; a.x = pk2(sv[8 * s2], sv[8 * s2 + 1]); a.y = pk2(sv[8 * s2 + 2], sv[8 * s2 + 3]); a.z = pk2(sv[8 * s2 + 4], sv[8 * s2 + 5]); a.w = pk2(sv[8 * s2 + 6], sv[8 * s2 + 7]); pf[s2] = __builtin_bit_cast(bf16x8, a); }
#pragma unroll
            for (int dt = 0; dt < 4; ++dt)
#pragma unroll
                for (int s2 = 0; s2 < 2; ++s2) { const u32x4 v4 = *(const LAS u32x4*)(ldsV + (32 * dt + q) * VP + (2 * hf + s2) * 32 + 16 * h);
                    o[dt] = MFMA32(__builtin_bit_cast(bf16x8, v4), pf[s2], o[dt]); }
        }
        if (more) { const int nb = ((kt + 1) & 1) * BUF;
            *(LAS u32x4*)(F.lds + nb + kl) = pk0; *(LAS u32x4*)(F.lds + nb + kl + 32 * KP) = pk1; *(LAS u32x2*)(F.lds + nb + vl) = (u32x2){pv0.x, pv0.y}; *(LAS u32x2*)(F.lds + nb + vl + 16) = (u32x2){pv0.z, pv0.w}; *(LAS u32x2*)(F.lds + nb + vl + 64 * VP) = (u32x2){pv1.x, pv1.y}; *(LAS u32x2*)(F.lds + nb + vl + 64 * VP + 16) = (u32x2){pv1.z, pv1.w}; }
        __syncthreads();
    }
    float inv = 1.0f / xsum32(lrun);
    unsigned char* yp = F.ws + WS_Y8 + rowq * 2048 + hq * 128;
    inv *= F8_SY;
#pragma unroll
    for (int dt = 0; dt < 4; ++dt) { unsigned w4[4];
#pragma unroll
        for (int gq = 0; gq < 4; ++gq) w4[gq] = pk4_fp8(o[dt][4 * gq] * inv, o[dt][4 * gq + 1] * inv, o[dt][4 * gq + 2] * inv, o[dt][4 * gq + 3] * inv);
        const auto r02 = __builtin_amdgcn_permlane32_swap(w4[0], w4[2], false, false); const auto r13 = __builtin_amdgcn_permlane32_swap(w4[1], w4[3], false, false);
        *(u32x4*)(yp + 32 * dt + 16 * h) = (u32x4){r02[0], r02[1], r13[0], r13[1]}; }
}

__device__ __forceinline__ void xattn_unit(Frame& F, int unit) {
    constexpr int KP = 528, VP = 144;
    const int tile = unit & 15, hx = (unit >> 4) & 3, b = unit >> 6;
    int tz = F.tid; asm volatile("" : "+v"(tz));
    const int w = F.wave, lane = tz & 63, fr = lane & 15, fq = lane >> 4;
    const size_t rowq = (size_t)(b * SEQ + tile * 128 + 16 * w + fr);
    const bf16_t* kx = (const bf16_t*)(F.ws + WS_KX); const bf16_t* vxT = (const bf16_t*)(F.ws + WS_VXT);
    bf16x8 qf[8];
    { const bf16_t* q0 = (const bf16_t*)(F.ws + WS_QX0) + rowq * 1024 + hx * 256 + 8 * fq; const bf16_t* q1 = (const bf16_t*)(F.ws + WS_QX1) + rowq * 1024 + hx * 256 + 8 * fq;
#pragma unroll
      for (int ds = 0; ds < 8; ++ds) { float a[8], c[8]; unpack8(*(const u32x4*)(q0 + 32 * ds), a); unpack8(*(const u32x4*)(q1 + 32 * ds), c);
#pragma unroll
          for (int j = 0; j < 8; ++j) a[j] += c[j];
          qf[ds] = __builtin_bit_cast(bf16x8, pack8(a)); } }
    f32x4 ot[16];
#pragma unroll
    for (int i = 0; i < 16; ++i) ot[i] = (f32x4){0.f, 0.f, 0.f, 0.f};
    float mrun = -1.0e30f, l = 0.f;
    LAS unsigned char* ldsK = F.lds; LAS unsigned char* ldsV = F.lds + 64 * KP;
    const bf16_t* kgp = kx + (size_t)(b * 256 + (tz >> 5)) * 1024 + hx * 256 + (tz & 31) * 8;
    const bf16_t* vgp = vxT + (size_t)(hx * 256 + (tz >> 3)) * 1024 + b * 256 + (tz & 7) * 8;
    const int klo = (tz >> 5) * KP + (tz & 31) * 16, vlo = 64 * KP + (tz >> 3) * VP + (tz & 7) * 16;
    u32x4 kr[4], vr[4];
#pragma unroll
    for (int k = 0; k < 4; ++k) { kr[k] = *(const u32x4*)(kgp + (size_t)(16 * k) * 1024); vr[k] = *(const u32x4*)(vgp + (size_t)(64 * k) * 1024); }
#pragma unroll 1
    for (int ch = 0; ch < 4; ++ch) {
        __syncthreads();
#pragma unroll
        for (int k = 0; k < 4; ++k) { *(LAS u32x4*)(F.lds + klo + 16 * k * KP) = kr[k]; *(LAS u32x4*)(F.lds + vlo + 64 * k * VP) = vr[k]; }
        if (ch < 3) {
#pragma unroll
            for (int k = 0; k < 4; ++k) { kr[k] = *(const u32x4*)(kgp + (size_t)((ch + 1) * 64 + 16 * k) * 1024); vr[k] = *(const u32x4*)(vgp + (size_t)(64 * k) * 1024 + (ch + 1) * 64); } }
        __syncthreads();
        f32x4 st[4];
#pragma unroll
        for (int k4 = 0; k4 < 4; ++k4) { st[k4] = (f32x4){0.f, 0.f, 0.f, 0.f};
#pragma unroll
            for (int ds = 0; ds < 8; ++ds) { const bf16x8 kf = *(const LAS bf16x8*)(ldsK + (16 * k4 + fr) * KP + (32 * ds + 8 * fq) * 2); st[k4] = MFMA16(kf, qf[ds], st[k4]); } }
        float mx = -1.0e30f;
#pragma unroll
        for (int i = 0; i < 4; ++i) mx = fmaxf(mx, fmaxf(fmaxf(st[i][0], st[i][1]), fmaxf(st[i][2], st[i][3])));
        mx = fmaxf(mx, shx(mx, lane, 16)); mx = fmaxf(mx, shx(mx, lane, 32));
        const float mnew = fmaxf(mrun, mx), alpha = __builtin_amdgcn_exp2f((mrun - mnew) * 1.4426950408889634f), mc = mnew * 1.4426950408889634f; mrun = mnew;
        float ps = 0.f;
#pragma unroll
        for (int i = 0; i < 4; ++i)
#pragma unroll
            for (int e = 0; e < 4; ++e) { st[i][e] = __builtin_amdgcn_exp2f(st[i][e] * 1.4426950408889634f - mc); ps += st[i][e]; }
        l = l * alpha + ps;
#pragma unroll
        for (int i = 0; i < 16; ++i) ot[i] *= alpha;
        bf16x8 pf[2];
#pragma unroll
        for (int k2 = 0; k2 < 2; ++k2) { u32x4 a; a.x = pk2(st[2 * k2][0], st[2 * k2][1]); a.y = pk2(st[2 * k2][2], st[2 * k2][3]); a.z = pk2(st[2 * k2 + 1][0], st[2 * k2 + 1][1]); a.w = pk2(st[2 * k2 + 1][2], st[2 * k2 + 1][3]); pf[k2] = __builtin_bit_cast(bf16x8, a); }
#pragma unroll
        for (int k2 = 0; k2 < 2; ++k2)
#pragma unroll
            for (int dt = 0; dt < 16; ++dt) { const LAS unsigned char* vp = ldsV + (16 * dt + fr) * VP + (32 * k2 + 4 * fq) * 2;
                const u32x2 a = *(const LAS u32x2*)vp, c = *(const LAS u32x2*)(vp + 32); u32x4 v4; v4.x = a.x; v4.y = a.y; v4.z = c.x; v4.w = c.y;
                ot[dt] = MFMA16(__builtin_bit_cast(bf16x8, v4), pf[k2], ot[dt]); }
    }
    l += shx(l, lane, 16); l += shx(l, lane, 32);
    const float inv = 1.0f / l;
    bf16_t* op = (bf16_t*)(F.ws + WS_OX) + rowq * 1024 + hx * 256 + 4 * fq;
#pragma unroll
    for (int dt = 0; dt < 16; ++dt) { u32x2 ow; ow.x = pk2(ot[dt][0] * inv, ot[dt][1] * inv); ow.y = pk2(ot[dt][2] * inv, ot[dt][3] * inv); *(u32x2*)(op + 16 * dt) = ow; }
}

__global__ void __launch_bounds__(512, 2) hybrid_fwd(Params P) {
    extern __shared__ __attribute__((aligned(16))) unsigned char lds_raw[];
    Frame F;
    F.lds = (LAS unsigned char*)lds_raw; F.tid = threadIdx.x; F.lane = F.tid & 63; F.wave = __builtin_amdgcn_readfirstlane(F.tid >> 6); F.G = gridDim.x; F.bid = blockIdx.x;
    F.ws = P.ws;
    volatile LAS unsigned* MISC = (volatile LAS unsigned*)(F.lds + LDSCTL_OFF);
    for (int u = F.tid; u < (LDS_BYTES - LDSCTL_OFF) / 4; u += 512) MISC[u] = 0u;
    __syncthreads();
    XcdBarrier bar; bar.bar = (unsigned*)(P.ws + WS_CTL) + CW_BAR; bar.x = 0; bar.st = nullptr;
    if (MK_N_LAUNCHES == 1) bar = xcd_barrier_post((unsigned*)(P.ws + WS_CTL) + CW_BAR, MISC + 8);
    const int lo = P.ph_lo, hi = P.ph_hi;
#define IN(k) ((((PH_MASK) >> (k)) & 1) && lo <= (k) && (k) < hi)
#define SEAM(k) do { if (IN(k) && IN((k) + 1)) xcd_barrier(bar); } while (0)
    const int G = F.G, c = F.bid;
    unsigned char* ws = P.ws;

    const int NFREE = (G >= 240) ? N_FREE_WG : 0, Gg = G - NFREE;
    if (IN(0)) { p0_prologue(F, P, NFREE == 0); if (DUP_PHASE == 0) { xcd_barrier(bar); p0_prologue(F, P, NFREE == 0); } } SEAM(0);

    if (IN(1)) {
        EpiProj<0> E0{F_PROJ, F_VT, (bf16_t*)(ws + WS_VTA), F_RSTDX, F_SSQV, F_ROPEB, F_ROPEI, (bf16_t*)(ws + WS_KX), (bf16_t*)(ws + WS_VXT), F_RSTDM, 1.0f};
        EpiProj<1> E8{F_PROJ, F_VT, (bf16_t*)(ws + WS_VTA), F_RSTDX, F_SSQV, F_ROPEB, F_ROPEI, (bf16_t*)(ws + WS_KX), (bf16_t*)(ws + WS_VXT), F_RSTDM, F8_INV};
        EpiProj<2> EK{F_PROJ, F_VT, (bf16_t*)(ws + WS_VTA), F_RSTDX, F_SSQV, F_ROPEB, F_ROPEI, (bf16_t*)(ws + WS_KX), (bf16_t*)(ws + WS_VXT), F_RSTDM, 1.0f};
        SchedKV SK{NFREE ? NFREE : G, NFREE ? c - Gg : c, (const char*)(ws + WS_MEMB), (const char*)(ws + WS_WK), (const char*)(ws + WS_WV)};
        if (c >= Gg) {
            pg8::gemm_phase<false>(F.lds, DM, DM, DM, SK, EK);
            convert_late(F, P, (unsigned*)(ws + CT_CVT));
        } else {
            const int rot = (1408 % Gg) & ~7;
            SchedZa SZ{Gg, c, (const char*)(ws + WS_XB), (const char*)(ws + WS_WIN)};
            pg8::gemm_phase<false>(F.lds, DM, DM, DM, SZ, E0);
            const int nb4 = 672 % Gg, e8 = 1408 % Gg; const bool bal = (Gg == 216);
            const int skip5 = bal && c < nb4, extra = (bal && c >= nb4 && c < 2 * nb4) ? (c - nb4 + rot) % Gg : -1;
            SchedF8 S8{Gg, (c + rot) % Gg, skip5, extra, (const char*)(ws + WS_XB8), (const char*)(ws + WS_WIN8)};
            pg8::gemm_phase<true>(F.lds, DM, DM, DM, S8, E8);
            if (!NFREE) pg8::gemm_phase<false>(F.lds, DM, DM, DM, SK, EK);
        }
    } SEAM(1);

    if (IN(2)) {
        for (int u = c; u < 256; u += G) { const int b = u >> 6, j = u & 63; indexer_unit(F, b, j); indexer_unit(F, b, 127 - j); }
        for (int u = c; u < 1024; u += G) spatial_unit(F, P, u);
        if (DUP_PHASE == 2) { xcd_barrier(bar);
            for (int u = c; u < 256; u += G) { const int b = u >> 6, j = u & 63; indexer_unit(F, b, j); indexer_unit(F, b, 127 - j); }
            for (int u = c; u < 1024; u += G) spatial_unit(F, P, u); }
    } SEAM(2);

    if (IN(3)) {
        for (int u = c; u < 256; u += G) { const int j = u & 15, kvh = (u >> 4) & 3, b = u >> 6; attn_unit(F, b, kvh, 31 - j); attn_unit(F, b, kvh, j); }
        if (DUP_PHASE == 3) { xcd_barrier(bar); for (int u = c; u < 256; u += G) { const int j = u & 15, kvh = (u >> 4) & 3, b = u >> 6; attn_unit(F, b, kvh, 31 - j); attn_unit(F, b, kvh, j); } }
    } SEAM(3);

    if (IN(4)) {
        EpiMerge E{F_MRG, F_PROJ};
        f32x4 acc4[2][2][4][2];
#define P4_TILE(L) do { if ((L) < 512) { Unit u; pg8::tile_of((L), 32, 16, u.pm, u.pn); \
            u.kind = 0; u.A = (const char*)F_Y + (size_t)u.pm * 256 * DM * 2; u.B = (const char*)(ws + WS_PA) + (size_t)u.pn * 256 * 2048 * 2; \
            { SchedOne S{u}; pg8::gemm_phase_acc<false>(F.lds, 2048, DM, 2048, S, E, acc4, true); }       \
            u.kind = 1; u.A = (const char*)(ws + WS_Y8) + (size_t)u.pm * 256 * 2048; u.B = (const char*)(ws + WS_PB) + (size_t)u.pn * 256 * 2048; \
            { SchedOne S{u}; pg8::gemm_phase_acc<true>(F.lds, 2048, 2048, 2048, S, E, acc4, false); } } } while (0)
        P4_TILE(c); P4_TILE(c + G);
        if (c + 2 * G < 512) __builtin_trap();
#undef P4_TILE
    } SEAM(4);

    if (IN(5)) {
        SchedSimple S{G, c, 32, 16, (const char*)F_MRG, (const char*)(ws + WS_WOUT), (size_t)256 * DM * 2, (size_t)256 * DM * 2};
        EpiResid<false> E{(const void*)(ws + WS_XB), (bf16_t*)(ws + WS_X1B), F_SSQ1};
        pg8::gemm_phase<false>(F.lds, DM, DM, DM, S, E);
    } SEAM(5);

    if (IN(6)) {
        SchedG6 S{G, c, (const char*)(ws + WS_X1B), (const char*)(ws + WS_WQ)};
        EpiQx E{(bf16_t*)(ws + WS_QX0), (bf16_t*)(ws + WS_QX1), F_SSQ1};
        pg8::gemm_phase<false>(F.lds, 2048, DM, DM, S, E);
        if (DUP_PHASE == 6) { xcd_barrier(bar); pg8::gemm_phase<false>(F.lds, 2048, DM, DM, S, E); }
    } SEAM(6);

    if (IN(7)) { for (int u = c; u < 256; u += G) xattn_unit(F, u); if (DUP_PHASE == 7) { xcd_barrier(bar); for (int u = c; u < 256; u += G) xattn_unit(F, u); } } SEAM(7);

    if (IN(8)) {
        SchedSimple S{G, c, 32, 16, (const char*)(ws + WS_OX), (const char*)(ws + WS_WO), (size_t)256 * 1024 * 2, (size_t)256 * 1024 * 2};
        EpiResid<false> E{(const void*)(ws + WS_X1B), (bf16_t*)(ws + WS_X2B), F_SSQ2};
        pg8::gemm_phase<false>(F.lds, 1024, 1024, 1024, S, E);
    } SEAM(8);

    if (IN(9)) {
        SchedSimple S{G, c, 32, 86, (const char*)(ws + WS_X2B), (const char*)(ws + WS_W13), (size_t)256 * DM * 2, (size_t)256 * DM * 2};
        EpiFfnUp E{(bf16_t*)(ws + WS_HDN), F_SSQ2};
        pg8::gemm_phase<false>(F.lds, DM, DM, DM, S, E);
        if (DUP_PHASE == 9) { xcd_barrier(bar); pg8::gemm_phase<false>(F.lds, DM, DM, DM, S, E); }
    } SEAM(9);

    if (IN(10)) {
        SchedSimple S{G, c, 32, 16, (const char*)(ws + WS_HDN), (const char*)(ws + WS_W2), (size_t)256 * FFN * 2, (size_t)256 * FFN * 2};
        EpiResid<false> E{(const void*)(ws + WS_X2B), (bf16_t*)(ws + WS_X3B), F_SSQ3};
        pg8::gemm_phase<false>(F.lds, FFN, FFN, FFN, S, E);
    } SEAM(10);

    if (IN(11)) {
        const int gw = c * 8 + F.wave, NGW = G * 8, lane = F.lane; const bf16_t* x3 = (const bf16_t*)(ws + WS_X3B);
        for (int m = gw; m < M; m += NGW) { const float rs = __builtin_amdgcn_rsqf(F_SSQ3[m] * (1.f / DM) + EPS);
#pragma unroll
            for (int j = 0; j < 8; ++j) { const int col = 512 * j + 8 * lane; float v[8]; unpack8(*(const u32x4*)(x3 + (size_t)m * DM + col), v);
                const f32x4 g0 = *(const f32x4*)(P.final_g + col), g1 = *(const f32x4*)(P.final_g + col + 4);
                f32x4 o0, o1; o0[0] = v[0] * rs * g0[0]; o0[1] = v[1] * rs * g0[1]; o0[2] = v[2] * rs * g0[2]; o0[3] = v[3] * rs * g0[3]; o1[0] = v[4] * rs * g1[0]; o1[1] = v[5] * rs * g1[1]; o1[2] = v[6] * rs * g1[2]; o1[3] = v[7] * rs * g1[3];
                *(f32x4*)(P.out + (size_t)m * DM + col) = o0; *(f32x4*)(P.out + (size_t)m * DM + col + 4) = o1; } }
    }
#undef IN
#undef SEAM
}

extern "C" void kernel_launch(void* const* d_in, const int* in_sizes, int n_in, void* d_out, int out_size, void* d_ws, size_t ws_size, hipStream_t stream) {
    static int grid = 0;
    if (grid == 0) {
        if (n_in != 22 || out_size != M * DM || ws_size < WS_END) { fprintf(stderr, "kernel_launch: unexpected problem (n_in %d, out %d, ws %zu)\n", n_in, out_size, ws_size); grid = -1; return; }
        int dev = 0, cus = 0, per_cu = 0;
        if (hipGetDevice(&dev) != hipSuccess || hipDeviceGetAttribute(&cus, hipDeviceAttributeMultiprocessorCount, dev) != hipSuccess) { grid = -1; return; }
        if (hipFuncSetAttribute((const void*)hybrid_fwd, hipFuncAttributeMaxDynamicSharedMemorySize, LDS_BYTES) != hipSuccess) { fprintf(stderr, "kernel_launch: hipFuncSetAttribute failed\n"); grid = -1; return; }
        if (hipOccupancyMaxActiveBlocksPerMultiprocessor(&per_cu, (const void*)hybrid_fwd, 512, LDS_BYTES) != hipSuccess || per_cu < 1) fprintf(stderr, "kernel_launch: occupancy query reports %d\n", per_cu);
        (void)hipGetLastError();
        grid = cus;
    }
    if (grid < 0) return;
    if (hipMemsetAsync((char*)d_ws + WS_CTL, 0, CTL_ZERO_BYTES, stream) != hipSuccess) return;
    Params p{};
    p.x = (const float*)d_in[0]; p.mem = (const float*)d_in[1]; p.pos = (const int*)d_in[2];
    p.norm_mix_g = (const float*)d_in[3]; p.w_in = (const float*)d_in[4]; p.a_norm_g = (const float*)d_in[5]; p.a_sw = (const float*)d_in[6]; p.a_sb = (const float*)d_in[7];
    p.p_a = (const float*)d_in[8]; p.p_b = (const float*)d_in[9]; p.w_out = (const float*)d_in[10]; p.norm_x_g = (const float*)d_in[11]; p.norm_mem_g = (const float*)d_in[12];
    p.xq = (const float*)d_in[13]; p.xk = (const float*)d_in[14]; p.xv = (const float*)d_in[15]; p.xo = (const float*)d_in[16]; p.norm_ffn_g = (const float*)d_in[17];
    p.w1 = (const float*)d_in[18]; p.w3 = (const float*)d_in[19]; p.w2 = (const float*)d_in[20]; p.final_g = (const float*)d_in[21];
    p.out = (float*)d_out; p.ws = (unsigned char*)d_ws;
    for (int li = 0; li < MK_N_LAUNCHES; ++li) {
        p.ph_lo = (MK_N_LAUNCHES == 1) ? 0 : li; p.ph_hi = (MK_N_LAUNCHES == 1) ? NPHASE : li + 1;
        hipLaunchKernelGGL(hybrid_fwd, dim3(grid), dim3(512), LDS_BYTES, stream, p);
    }
}
```

```cpp
#include <hip/hip_runtime.h>
#include <cstdio>
#include <cstdint>

#ifndef MK_N_LAUNCHES
#define MK_N_LAUNCHES 1
#endif

#ifndef DUP_PHASE
#define DUP_PHASE -1
#endif
#ifndef PH_MASK
#define PH_MASK 0xFFF
#endif
#define LAS __attribute__((address_space(3)))
#define GAS __attribute__((address_space(1)))
typedef unsigned short bf16_t;
typedef short bf16x8 __attribute__((ext_vector_type(8)));
typedef float f32x4 __attribute__((ext_vector_type(4)));
typedef float f32x16 __attribute__((ext_vector_type(16)));
typedef unsigned u32x4 __attribute__((ext_vector_type(4)));
typedef unsigned u32x2 __attribute__((ext_vector_type(2)));
typedef int v8i __attribute__((ext_vector_type(8)));
typedef __bf16 bf16x2_t __attribute__((ext_vector_type(2)));
typedef float f32x2_t __attribute__((ext_vector_type(2)));

constexpr int NB = 4, SEQ = 2048, M = NB * SEQ, DM = 4096, MEMR = 1024;
constexpr int NPROJ = 16640;
constexpr int C_U = 0, C_V = 2048, C_Q = 4096, C_K = 6144, C_VV = 6656, C_QI = 7168, C_KI = 8192, C_WI = 8256, C_GA = 8448, C_GB = 12544;
constexpr int FFN = 11008, N13 = 22016;
constexpr float EPS = 1e-6f;
constexpr int NPHASE = 12;

constexpr size_t MiB = 1u << 20;
constexpr size_t WS_CTL = 0, CTL_ZERO_BYTES = 1 * MiB;
constexpr int CW_BAR = 4096;
constexpr size_t CT_CVT = 32768;
constexpr size_t CT_SSQV = 65536, CT_SSQ1 = 98304, CT_SSQ2 = 131072, CT_SSQ3 = 163840;
constexpr size_t WS_RSTDX = 1 * MiB, WS_RSTDM = 1 * MiB + 65536, WS_ROPEB = 2 * MiB, WS_ROPEI = 3 * MiB, WS_WC = 3 * MiB + 524288, WS_MASK = 4 * MiB;
constexpr size_t WS_VT = 6 * MiB, WS_MEMB = 14 * MiB, WS_WIN = 22 * MiB, WS_PA = 152 * MiB, WS_PB = 168 * MiB, WS_WOUT = 184 * MiB;
constexpr size_t WS_WQ = 216 * MiB, WS_WK = 224 * MiB, WS_WV = 232 * MiB, WS_WO = 240 * MiB, WS_W13 = 248 * MiB, WS_W2 = 420 * MiB;
constexpr size_t WS_XB = 506 * MiB, WS_PROJ = 570 * MiB, WS_Y = 830 * MiB, WS_MRG = 894 * MiB, WS_KX = 958 * MiB, WS_VXT = 960 * MiB, WS_VTA = 962 * MiB, WS_Y8 = 994 * MiB, WS_END = 1010 * MiB;
constexpr size_t WS_WIN8 = 64 * MiB, WS_XB8 = WS_Y;
constexpr float F8_SA = 16.f, F8_SB = 1024.f, F8_INV = 1.f / (16.f * 1024.f), F8_SY = 64.f, F8_SPB = 512.f, F8_SYP = 64.f * 512.f, F8_IYP = 1.f / (64.f * 512.f);
constexpr size_t WS_HDN = WS_PROJ, WS_X1B = WS_Y, WS_X3B = WS_Y, WS_X2B = WS_XB, WS_QX0 = WS_MRG, WS_QX1 = WS_MRG + 16 * MiB, WS_OX = WS_MRG + 32 * MiB;
static_assert(WS_WIN + (size_t)NPROJ * DM * 2 <= WS_PA && WS_W13 + (size_t)N13 * DM * 2 <= WS_W2 && WS_W2 + (size_t)DM * FFN * 2 <= WS_XB, "weights map");
static_assert(WS_PROJ + (size_t)M * NPROJ * 2 <= WS_Y && WS_HDN + (size_t)M * FFN * 2 <= WS_Y, "proj map");

constexpr int RING_BYTES = 139264;
constexpr int LDSCTL_OFF = RING_BYTES, LDS_BYTES = RING_BYTES + 512;

__device__ __forceinline__ unsigned pk2(float lo, float hi) { f32x2_t v = {lo, hi}; bf16x2_t b = __builtin_convertvector(v, bf16x2_t); return __builtin_bit_cast(unsigned, b); }
__device__ __forceinline__ float bf_lo(unsigned w) { return __uint_as_float(w << 16); }
__device__ __forceinline__ float bf_hi(unsigned w) { return __uint_as_float(w & 0xffff0000u); }
__device__ __forceinline__ float bf1(bf16_t b) { return __uint_as_float(((unsigned)b) << 16); }
__device__ __forceinline__ void unpack8(const u32x4 r, float (&f)[8]) { f[0] = bf_lo(r.x); f[1] = bf_hi(r.x); f[2] = bf_lo(r.y); f[3] = bf_hi(r.y); f[4] = bf_lo(r.z); f[5] = bf_hi(r.z); f[6] = bf_lo(r.w); f[7] = bf_hi(r.w); }
__device__ __forceinline__ u32x4 pack8(const float (&f)[8]) { u32x4 w; w.x = pk2(f[0], f[1]); w.y = pk2(f[2], f[3]); w.z = pk2(f[4], f[5]); w.w = pk2(f[6], f[7]); return w; }
__device__ __forceinline__ unsigned pk4_fp8(float a, float b, float c, float d) { int w = 0; w = __builtin_amdgcn_cvt_pk_fp8_f32(a, b, w, false); w = __builtin_amdgcn_cvt_pk_fp8_f32(c, d, w, true); return (unsigned)w; }
__device__ __forceinline__ float sigmoidf_(float x) { return __builtin_amdgcn_rcpf(1.f + __builtin_amdgcn_exp2f(-1.44269504f * x)); }
__device__ __forceinline__ float gelu_tanh(float x) { const float z = 1.5957691216f * x * (1.f + 0.044715f * x * x); return x * sigmoidf_(z); }
__device__ __forceinline__ float wave_sum(float v) {
#pragma unroll
    for (int o = 1; o < 64; o <<= 1) v += __shfl_xor(v, o);
    return v;
}
__device__ __forceinline__ float shx(float v, int lane, int m) { return __int_as_float(__builtin_amdgcn_ds_bpermute(((lane ^ m) & 63) << 2, __float_as_int(v))); }
__device__ __forceinline__ float xmax32(float t) { const auto r = __builtin_amdgcn_permlane32_swap(__float_as_uint(t), __float_as_uint(t), false, false); return fmaxf(__uint_as_float(r[0]), __uint_as_float(r[1])); }
__device__ __forceinline__ float xsum32(float t) { const auto r = __builtin_amdgcn_permlane32_swap(__float_as_uint(t), __float_as_uint(t), false, false); return __uint_as_float(r[0]) + __uint_as_float(r[1]); }
#define LDS_WAIT() asm volatile("s_waitcnt lgkmcnt(0)" ::: "memory")
#define MFMA32(a, b, c) __builtin_amdgcn_mfma_f32_32x32x16_bf16((a), (b), (c), 0, 0, 0)
#define MFMA16(a, b, c) __builtin_amdgcn_mfma_f32_16x16x32_bf16((a), (b), (c), 0, 0, 0)

#define XB_TMO      128
#define XB_XCNT(j)  (256  + 64 * (j))
#define XB_XSUB(j)  (1280 + 64 * (j))
#define XB_XGEN(j)  (2304 + 64 * (j))
#define XB_TOP      3328
#define XB_TOPGEN   3392
#define XCD_BAR_WORDS 3456
#define XB_SPIN_CAP (1u << 18)
__device__ __forceinline__ unsigned xb_ld(unsigned* p)              { return __hip_atomic_load(p, __ATOMIC_RELAXED, __HIP_MEMORY_SCOPE_AGENT); }
__device__ __forceinline__ unsigned xb_add(unsigned* p, unsigned v) { return __hip_atomic_fetch_add(p, v, __ATOMIC_RELAXED, __HIP_MEMORY_SCOPE_AGENT); }
__device__ __forceinline__ unsigned xb_xcc_id() { return (unsigned)__builtin_amdgcn_s_getreg((3 << 11) | 20) & 0xFu; }
#define XB_SPIN(cond, bar) do { unsigned _sp = 0; while (cond) { __builtin_amdgcn_s_sleep(1); \
    if ((++_sp & 255u) == 0u) { if (xb_ld(&(bar)[XB_TMO])) break; if (_sp > XB_SPIN_CAP) { atomicAdd(&(bar)[XB_TMO], 1u); break; } } } } while (0)
struct XcdBarrier { unsigned* bar; unsigned x; volatile LAS unsigned* st; };
__device__ __forceinline__ XcdBarrier xcd_barrier_post(unsigned* bar, volatile LAS unsigned* st) {
    XcdBarrier b; b.bar = bar; b.x = xb_xcc_id(); b.st = st;
    if (threadIdx.x == 0) (void)xb_add(&bar[XB_XCNT(b.x)], 1u);
    return b;
}
__device__ __forceinline__ void xcd_barrier_complete(unsigned* bar, unsigned x, unsigned& nloc, unsigned& nx) {
    const unsigned G = gridDim.x * gridDim.y * gridDim.z;
    unsigned sum, cnt, mine, sp = 0u;
    for (;;) {
        sum = 0u; cnt = 0u; mine = 0u;
#pragma unroll
        for (unsigned j = 0; j < 16; ++j) { const unsigned c = xb_ld(&bar[XB_XCNT(j)]); sum += c; cnt += (c > 0u) ? 1u : 0u; mine = (j == x) ? c : mine; }
        if (sum == G) break;
        __builtin_amdgcn_s_sleep(1);
        if ((++sp & 255u) == 0u) { if (xb_ld(&bar[XB_TMO])) break; if (sp > XB_SPIN_CAP) { atomicAdd(&bar[XB_TMO], 1u); break; } }
    }
    nloc = mine > 0u ? mine : 1u; nx = cnt > 0u ? cnt : 1u;
}
__device__ __forceinline__ void xcd_barrier(const XcdBarrier& b) {
    asm volatile("s_waitcnt vmcnt(0)" ::: "memory");
    __syncthreads();
    if (threadIdx.x == 0) {
        unsigned* bar = b.bar;
        __builtin_amdgcn_s_waitcnt(0);
        unsigned nloc = b.st[0], nx = b.st[1];
        if (nloc == 0u) { xcd_barrier_complete(bar, b.x, nloc, nx); b.st[0] = nloc; b.st[1] = nx; }
        const unsigned old = xb_add(&bar[XB_XSUB(b.x)], 1u);
        const unsigned gen = old / nloc;
        if (old + 1u == (gen + 1u) * nloc) {
            __builtin_amdgcn_fence(__ATOMIC_RELEASE, "agent");
            asm volatile("s_waitcnt vmcnt(0)" ::: "memory");
            const unsigned og = xb_add(&bar[XB_TOP], 1u);
            const unsigned tg = og / nx;
            if (og + 1u == (tg + 1u) * nx) xb_add(&bar[XB_TOPGEN], 1u);
            else XB_SPIN(xb_ld(&bar[XB_TOPGEN]) == tg, bar);
            __builtin_amdgcn_fence(__ATOMIC_ACQUIRE, "agent");
            xb_add(&bar[XB_XGEN(b.x)], 1u);
            asm volatile("s_waitcnt vmcnt(0)" ::: "memory");
        } else {
            XB_SPIN(xb_ld(&bar[XB_XGEN(b.x)]) == gen, bar);
            __builtin_amdgcn_fence(__ATOMIC_ACQUIRE, "agent");
            asm volatile("s_waitcnt vmcnt(0)" ::: "memory");
        }
    }
    __syncthreads();
}

namespace pg8 {
constexpr int BM = 256, BK = 64, HALF = 128, HTB = HALF * BK * 2, STAGE_BYTES = 8 * HTB;
__device__ __forceinline__ int lds_byte(int r, int c) { const int st = (r >> 4) * 2 + (c >> 5), rr = r & 15, cc = c & 31, ob = rr * 64 + cc * 2; return st * 1024 + (ob ^ (((ob >> 9) & 1) << 5)); }
__device__ __forceinline__ void stage_rc(int b, int& R, int& C) { const int st = b / 1024, sb = b % 1024, swz = sb ^ (((sb >> 9) & 1) << 5); R = (st >> 1) * 16 + swz / 64; C = (st & 1) * 32 + (swz % 64) / 2; }
__device__ __forceinline__ int perm32(int rho) { const int n = rho >> 4, i = rho & 15; return 8 * (i >> 2) + 4 * n + (i & 3); }
struct Unit { const char* A; const char* B; int pm, pn, kind; };
__device__ __forceinline__ void tile_of(int L, int nM, int nN, int& pm, int& pn) {
    const int nwg = nM * nN; int wgid = L;
    { const int q = nwg / 8, r = nwg % 8, xcd = wgid % 8, off = wgid / 8; wgid = (xcd < r ? xcd * (q + 1) : r * (q + 1) + (xcd - r) * q) + off; }
    const int nig = 8 * nN, gid = wgid / nig, fm = gid * 8, gsz = (nM - fm) < 8 ? (nM - fm) : 8;
    pm = fm + ((wgid % nig) % gsz); pn = (wgid % nig) / gsz;
}
template <bool F8, class Epi, class Sched>
__device__ __forceinline__ void gemm_phase_acc(LAS unsigned char* lds, const int K, const int lda, const int ldb, const Sched& S, const Epi& E, f32x4 (&acc)[2][2][4][2], const bool zero_first) {
    int tid = threadIdx.x; asm volatile("" : "+v"(tid));
    const int wid = __builtin_amdgcn_readfirstlane(tid >> 6), lane = tid & 63, wr = wid >> 2, wc = wid & 3, fr = lane & 15, fq = lane >> 4;
    constexpr int EB = F8 ? 1 : 2;
    const int nt = K * EB / (BK * 2);
    unsigned voffA[2], voffB[2];
#pragma unroll
    for (int i = 0; i < 2; ++i) { int R, C; stage_rc(tid * 16 + i * 8192, R, C); const int Rb = (R & ~31) + perm32(R & 31);
        voffA[i] = (unsigned)(R * lda * EB + C * 2); voffB[i] = (unsigned)(Rb * ldb * EB + C * 2); }
    const size_t kstep = (size_t)(BK * 2);
    const size_t hstepA = (size_t)HALF * lda * EB, hstepB = (size_t)HALF * ldb * EB;
    const unsigned ldsw = (unsigned)wid * 1024u;
    const unsigned ldsbase = (unsigned)(unsigned long)lds;
    const int aoff = F8 ? lds_byte(wr * 64 + fr, fq * 16) : lds_byte(wr * 64 + fr, fq * 8), boff = F8 ? lds_byte(wc * 32 + fr, fq * 16) : lds_byte(wc * 32 + fr, fq * 8);
    constexpr int KOFF = F8 ? 16 : 1024;
    const int sw8 = F8 ? 16 * (fq & 1) : 0, aoffx = aoff + sw8, boffx = boff + sw8, aoffy = aoff + KOFF - sw8, boffy = boff + KOFF - sw8;
#define PG8_SA(b, h) (((b) * 2 + (h)) * HTB)
#define PG8_SB(b, h) ((4 + (b) * 2 + (h)) * HTB)
#define PG8_STAGE(bufoff, gbase, voff) do { _Pragma("unroll") for (int _i = 0; _i < 2; ++_i) \
        __builtin_amdgcn_global_load_lds((const unsigned*)((const char*)(gbase) + (voff)[_i]), (LAS unsigned*)(lds + (bufoff) + ldsw + _i * 8192), 16, 0, 0); } while (0)
#define PG8_STAGE8(bufoff, gbase, voff) do { _Pragma("unroll") for (int _i = 0; _i < 2; ++_i) { unsigned _keep; \
        asm volatile("s_mov_b32 %0, m0\n\ts_mov_b32 m0, %3\n\ts_nop 0\n\tglobal_load_lds_dwordx4 %1, %2\n\ts_mov_b32 m0, %0" : "=&s"(_keep) : "v"((voff)[_i]), "s"((const char*)(gbase)), "s"(ldsbase + (unsigned)(bufoff) + ldsw + _i * 8192u)); } } while (0)
#define PG8_LDA(dst, b, h) do { _Pragma("unroll") for (int m = 0; m < 4; ++m) _Pragma("unroll") for (int k = 0; k < 2; ++k) dst[m][k] = *(const LAS bf16x8*)(lds + PG8_SA(b, h) + aoff + m * 2048 + k * KOFF); } while (0)
#define PG8_LDB(dst, b, h) do { _Pragma("unroll") for (int n = 0; n < 2; ++n) _Pragma("unroll") for (int k = 0; k < 2; ++k) dst[n][k] = *(const LAS bf16x8*)(lds + PG8_SB(b, h) + boff + n * 2048 + k * KOFF); } while (0)
#define PG8_MMA(ai, bj, At, Bt) do { __builtin_amdgcn_s_setprio(1); _Pragma("unroll") for (int m = 0; m < 4; ++m) _Pragma("unroll") for (int n = 0; n < 2; ++n) { \
        if constexpr (F8) { const u32x4 _b0 = __builtin_bit_cast(u32x4, Bt[n][0]), _b1 = __builtin_bit_cast(u32x4, Bt[n][1]), _a0 = __builtin_bit_cast(u32x4, At[m][0]), _a1 = __builtin_bit_cast(u32x4, At[m][1]); \
            const v8i _bb = {(int)_b0.x, (int)_b0.y, (int)_b0.z, (int)_b0.w, (int)_b1.x, (int)_b1.y, (int)_b1.z, (int)_b1.w}, _aa = {(int)_a0.x, (int)_a0.y, (int)_a0.z, (int)_a0.w, (int)_a1.x, (int)_a1.y, (int)_a1.z, (int)_a1.w}; \
            acc[ai][bj][m][n] = __builtin_amdgcn_mfma_scale_f32_16x16x128_f8f6f4(_bb, _aa, acc[ai][bj][m][n], 0, 0, 0, 0, 0, 0); } \
        else { _Pragma("unroll") for (int k = 0; k < 2; ++k) acc[ai][bj][m][n] = __builtin_amdgcn_mfma_f32_16x16x32_bf16(Bt[n][k], At[m][k], acc[ai][bj][m][n], 0, 0, 0); } } \
        __builtin_amdgcn_s_setprio(0); } while (0)
#define PG8_WAIT_V(n) asm volatile("s_waitcnt vmcnt(" #n ")" ::: "memory")
#define PG8_WAIT_L(n) asm volatile("s_waitcnt lgkmcnt(" #n ")" ::: "memory")
#define PG8_BAR __builtin_amdgcn_s_barrier()
#define PG8_SCHED __builtin_amdgcn_sched_barrier(0)
    Unit cur, nxt; int ui = 0;
    if (!S.next(0, cur)) return;
    if (zero_first) {
#pragma unroll
    for (int a = 0; a < 2; ++a)
#pragma unroll
        for (int b = 0; b < 2; ++b)
#pragma unroll
            for (int m = 0; m < 4; ++m)
#pragma unroll
                for (int n = 0; n < 2; ++n) acc[a][b][m][n] = (f32x4){0.f, 0.f, 0.f, 0.f};
    }
    bf16x8 At[4][2], B0[2][2], B1[2][2];
    const char* cA = cur.A; const char* cB = cur.B;
    if constexpr (F8) {
    PG8_STAGE8(PG8_SB(0, 0), cB, voffB); PG8_STAGE8(PG8_SB(0, 1), cB + hstepB, voffB); PG8_STAGE8(PG8_SA(0, 0), cA, voffA); PG8_STAGE8(PG8_SA(0, 1), cA + hstepA, voffA);
    if (wr == 1) PG8_BAR;
    PG8_WAIT_V(2); PG8_BAR;
    PG8_STAGE8(PG8_SB(1, 0), cB + kstep, voffB); PG8_STAGE8(PG8_SA(1, 0), cA + kstep, voffA); PG8_STAGE8(PG8_SB(1, 1), cB + hstepB + kstep, voffB);
    PG8_WAIT_V(6); PG8_BAR;
    } else {
    PG8_STAGE(PG8_SB(0, 0), cB, voffB); PG8_STAGE(PG8_SB(0, 1), cB + hstepB, voffB); PG8_STAGE(PG8_SA(0, 0), cA, voffA); PG8_STAGE(PG8_SA(0, 1), cA + hstepA, voffA);
    if (wr == 1) PG8_BAR;
    PG8_WAIT_V(2); PG8_BAR;
    PG8_STAGE(PG8_SB(1, 0), cB + kstep, voffB); PG8_STAGE(PG8_SA(1, 0), cA + kstep, voffA); PG8_STAGE(PG8_SB(1, 1), cB + hstepB + kstep, voffB);
    PG8_WAIT_V(6); PG8_BAR;
    }
    for (;;) {
        const bool has_next = S.next(ui + 1, nxt);
        const char* nA = has_next ? nxt.A : cA; const char* nB = has_next ? nxt.B : cB;
        if constexpr (F8) {
        __builtin_amdgcn_s_waitcnt(0x0F70);
#pragma clang loop unroll(disable)
        for (int t = 0; t < nt; ++t) {
            const unsigned bo = (unsigned)(t & 1) * 32768u, bo1 = bo ^ 32768u;
            const char* a1 = (t + 1 < nt) ? cA + (size_t)(t + 1) * kstep : nA + (size_t)(t + 1 - nt) * kstep;
            const char* a2 = (t + 2 < nt) ? cA + (size_t)(t + 2) * kstep : nA + (size_t)(t + 2 - nt) * kstep;
            const char* b2 = (t + 2 < nt) ? cB + (size_t)(t + 2) * kstep : nB + (size_t)(t + 2 - nt) * kstep;
#define PG8_RLD(dst, NR, off, base) do { _Pragma("unroll") for (int q = 0; q < NR; ++q) _Pragma("unroll") for (int k = 0; k < 2; ++k) dst[q][k] = *(const LAS bf16x8*)(lds + (k ? base##y : base##x) + (off) + q * 2048); } while (0)
            PG8_RLD(B0, 2, bo + 4 * HTB, boff); PG8_RLD(B1, 2, bo + 5 * HTB, boff); PG8_SCHED; PG8_RLD(At, 4, bo, aoff); PG8_STAGE8(bo1 + HTB, a1 + hstepA, voffA);
            PG8_WAIT_V(8); PG8_WAIT_L(0); PG8_BAR; PG8_MMA(0, 0, At, B0); PG8_MMA(0, 1, At, B1); PG8_BAR; PG8_SCHED;
            PG8_RLD(At, 4, bo + HTB, aoff); PG8_STAGE8(bo + 4 * HTB, b2, voffB); PG8_STAGE8(bo + 5 * HTB, b2 + hstepB, voffB); PG8_STAGE8(bo, a2, voffA);
            PG8_WAIT_V(8); PG8_WAIT_L(0); PG8_BAR; PG8_MMA(1, 0, At, B0); PG8_MMA(1, 1, At, B1); PG8_BAR; PG8_SCHED;
#undef PG8_RLD
        }
        } else
        for (int t = 0; t < nt; t += 2) {
            const bool last = (t == nt - 2);
            const char* a1 = cA + (size_t)(t + 1) * kstep;
            const char* a2 = last ? nA : cA + (size_t)(t + 2) * kstep; const char* b2 = last ? nB : cB + (size_t)(t + 2) * kstep;
            const char* a3 = a2 + kstep; const char* b3 = b2 + kstep;
            PG8_LDB(B0, 0, 0); PG8_LDB(B1, 0, 1); PG8_SCHED; PG8_LDA(At, 0, 0); PG8_STAGE(PG8_SA(1, 1), a1 + hstepA, voffA);
            PG8_WAIT_V(8); PG8_WAIT_L(0); PG8_BAR; PG8_MMA(0, 0, At, B0); PG8_MMA(0, 1, At, B1); PG8_BAR; PG8_SCHED;
            PG8_LDA(At, 0, 1); PG8_STAGE(PG8_SB(0, 0), b2, voffB); PG8_STAGE(PG8_SB(0, 1), b2 + hstepB, voffB); PG8_STAGE(PG8_SA(0, 0), a2, voffA);
            PG8_WAIT_V(8); PG8_WAIT_L(0); PG8_BAR; PG8_MMA(1, 0, At, B0); PG8_MMA(1, 1, At, B1); PG8_BAR; PG8_SCHED;
            PG8_LDB(B0, 1, 0); PG8_LDB(B1, 1, 1); PG8_SCHED; PG8_LDA(At, 1, 0); PG8_STAGE(PG8_SA(0, 1), a2 + hstepA, voffA);
            PG8_WAIT_V(8); PG8_WAIT_L(0); PG8_BAR; PG8_MMA(0, 0, At, B0); PG8_MMA(0, 1, At, B1); PG8_BAR; PG8_SCHED;
            PG8_LDA(At, 1, 1); PG8_STAGE(PG8_SB(1, 0), b3, voffB); PG8_STAGE(PG8_SB(1, 1), b3 + hstepB, voffB); PG8_STAGE(PG8_SA(1, 0), a3, voffA);
            PG8_WAIT_V(8); PG8_WAIT_L(0); PG8_BAR; PG8_MMA(1, 0, At, B0); PG8_MMA(1, 1, At, B1); PG8_BAR; PG8_SCHED;
        }
        if (wr == 0) PG8_BAR;
        bool keep = false;
        int tz = tid; asm volatile("" : "+v"(tz));
        const int fr2 = tz & 15, fq2 = (tz & 63) >> 4;
        if constexpr (Epi::CONT) { keep = (cur.kind == 0); if (keep) E.mid(acc, cur, wr, wc, fr2, fq2); else E(acc, cur, wr, wc, fr2, fq2); }
        else E(acc, cur, wr, wc, fr2, fq2);
        if (!has_next) break;
        if (!keep) {
#pragma unroll
        for (int a = 0; a < 2; ++a)
#pragma unroll
            for (int b = 0; b < 2; ++b)
#pragma unroll
                for (int m = 0; m < 4; ++m)
#pragma unroll
                    for (int n = 0; n < 2; ++n) acc[a][b][m][n] = (f32x4){0.f, 0.f, 0.f, 0.f};
        }
        cur = nxt; cA = nA; cB = nB; ++ui;
        if (wr == 1) PG8_BAR;
    }
    PG8_WAIT_V(0);
    PG8_BAR;
#undef PG8_SA
#undef PG8_SB
#undef PG8_STAGE
#undef PG8_STAGE8
#undef PG8_LDA
#undef PG8_LDB
#undef PG8_MMA
#undef PG8_WAIT_V
#undef PG8_WAIT_L
#undef PG8_BAR
#undef PG8_SCHED
}
template <bool F8, class Epi, class Sched>
__device__ __forceinline__ void gemm_phase(LAS unsigned char* lds, const int K, const int lda, const int ldb, const Sched& S, const Epi& E) {
    f32x4 acc[2][2][4][2];
    gemm_phase_acc<F8>(lds, K, lda, ldb, S, E, acc, true);
}
}
using pg8::Unit;

struct Params {
    const float *x, *mem; const int* pos;
    const float *norm_mix_g, *w_in, *a_norm_g, *a_sw, *a_sb, *p_a, *p_b, *w_out, *norm_x_g, *norm_mem_g, *xq, *xk, *xv, *xo, *norm_ffn_g, *w1, *w3, *w2, *final_g;
    float* out; unsigned char* ws;
    int ph_lo, ph_hi;
};
struct Frame {
    LAS unsigned char* lds;
    int tid, lane, wave, G, bid;
    unsigned char* ws;
};
#define F_PROJ ((bf16_t*)(F.ws + WS_PROJ))
#define F_VT ((bf16_t*)(F.ws + WS_VT))
#define F_Y ((bf16_t*)(F.ws + WS_Y))
#define F_MRG ((bf16_t*)(F.ws + WS_MRG))
#define F_SSQV ((float*)(F.ws + CT_SSQV))
#define F_SSQ1 ((float*)(F.ws + CT_SSQ1))
#define F_SSQ2 ((float*)(F.ws + CT_SSQ2))
#define F_SSQ3 ((float*)(F.ws + CT_SSQ3))
#define F_RSTDX ((float*)(F.ws + WS_RSTDX))
#define F_RSTDM ((float*)(F.ws + WS_RSTDM))
#define F_ROPEB ((float*)(F.ws + WS_ROPEB))
#define F_ROPEI ((float*)(F.ws + WS_ROPEI))
#define F_MASK ((unsigned*)(F.ws + WS_MASK))

#define EPI_ROW(ai, m) (u.pm * 256 + (ai) * 128 + wr * 64 + (m) * 16 + fr)
#define EPI_COL(bj) (u.pn * 256 + (bj) * 128 + wc * 32 + 8 * fq)
#define EPI_LOAD8(v, ai, bj, m, s) do { const f32x4 _a = acc[ai][bj][m][0], _b = acc[ai][bj][m][1]; v[0] = _a[0] * (s); v[1] = _a[1] * (s); v[2] = _a[2] * (s); v[3] = _a[3] * (s); v[4] = _b[0] * (s); v[5] = _b[1] * (s); v[6] = _b[2] * (s); v[7] = _b[3] * (s); } while (0)

template <int PART>
struct EpiProj {
    static constexpr bool CONT = false;
    bf16_t* proj; bf16_t* vT; bf16_t* vTa; const float* rstd_x; float* ssq_v; const float* rope_b; const float* rope_i; bf16_t* kx; bf16_t* vxT; const float* rstd_m; float asc;
    __device__ __forceinline__ void operator()(const f32x4 (&acc)[2][2][4][2], const Unit& u, int wr, int wc, int fr, int fq) const {
        if constexpr (PART == 2) {
        if (u.kind == 1) {
#pragma unroll
            for (int ai = 0; ai < 2; ++ai)
#pragma unroll
                for (int m = 0; m < 4; ++m) { const int row = EPI_ROW(ai, m); const float rs = rstd_m[row];
#pragma unroll
                    for (int bj = 0; bj < 2; ++bj) { float v[8]; EPI_LOAD8(v, ai, bj, m, rs); *(u32x4*)(kx + (size_t)row * 1024 + EPI_COL(bj)) = pack8(v); } }
            return;
        }
        if (u.kind == 2) {
#pragma unroll
            for (int bj = 0; bj < 2; ++bj) { const int c0 = EPI_COL(bj); const f32x4 s0 = *(const f32x4*)(rstd_m + c0), s1 = *(const f32x4*)(rstd_m + c0 + 4);
#pragma unroll
                for (int ai = 0; ai < 2; ++ai)
#pragma unroll
                    for (int m = 0; m < 4; ++m) { const int row = EPI_ROW(ai, m); float v[8]; EPI_LOAD8(v, ai, bj, m, 1.f);
                        v[0] *= s0[0]; v[1] *= s0[1]; v[2] *= s0[2]; v[3] *= s0[3]; v[4] *= s1[0]; v[5] *= s1[1]; v[6] *= s1[2]; v[7] *= s1[3];
                        *(u32x4*)(vxT + (size_t)row * 1024 + c0) = pack8(v); } }
            return;
        }
        } else {
        const int pn = (PART == 0 && u.pn >= 16) ? u.pn + 12 : u.pn;
        if (PART == 0 && u.pn < 16) {
#pragma unroll
            for (int ai = 0; ai < 2; ++ai)
#pragma unroll
                for (int m = 0; m < 4; ++m) { const int row = EPI_ROW(ai, m); const float rs = rstd_x[row] * asc; float ss = 0.f;
#pragma unroll
                    for (int bj = 0; bj < 2; ++bj) { float v[8]; EPI_LOAD8(v, ai, bj, m, rs);
#pragma unroll
                        for (int j = 0; j < 8; ++j) { v[j] = gelu_tanh(v[j]); ss += v[j] * v[j]; }
                        const u32x4 w = pack8(v);
                        if (pn < 8) *(u32x4*)(proj + (size_t)row * NPROJ + EPI_COL(bj)) = w;
                        else { const int cc = (pn - 8) * 256 + bj * 128 + wc * 32 + 8 * fq; bf16_t* tp = vTa + ((size_t)((row >> 11) * 2048 + cc)) * 2048 + (row & 2047);
                            tp[0] = (bf16_t)(w.x & 0xffffu); tp[2048] = (bf16_t)(w.x >> 16); tp[2 * 2048] = (bf16_t)(w.y & 0xffffu); tp[3 * 2048] = (bf16_t)(w.y >> 16);
                            tp[4 * 2048] = (bf16_t)(w.z & 0xffffu); tp[5 * 2048] = (bf16_t)(w.z >> 16); tp[6 * 2048] = (bf16_t)(w.w & 0xffffu); tp[7 * 2048] = (bf16_t)(w.w >> 16); } }
                    if (pn >= 8) { ss += __shfl_xor(ss, 16); ss += __shfl_xor(ss, 32); if (fq == 0) atomicAdd(ssq_v + row, ss); } }
        } else if (PART == 1 && pn < 26) {
#pragma unroll
            for (int ai = 0; ai < 2; ++ai)
#pragma unroll
                for (int m = 0; m < 4; ++m) { const int row = EPI_ROW(ai, m); const float rs = rstd_x[row] * asc;
                    const f32x4 c0 = *(const f32x4*)(rope_b + (size_t)row * 32 + 8 * (fq & 1)), c1 = *(const f32x4*)(rope_b + (size_t)row * 32 + 8 * (fq & 1) + 4);
                    const f32x4 s0 = *(const f32x4*)(rope_b + (size_t)row * 32 + 16 + 8 * (fq & 1)), s1 = *(const f32x4*)(rope_b + (size_t)row * 32 + 16 + 8 * (fq & 1) + 4);
                    const float cs[8] = {c0[0], c0[1], c0[2], c0[3], c1[0], c1[1], c1[2], c1[3]}, sn[8] = {s0[0], s0[1], s0[2], s0[3], s1[0], s1[1], s1[2], s1[3]};
#pragma unroll
                    for (int bj = 0; bj < 2; ++bj) { float v[8]; EPI_LOAD8(v, ai, bj, m, rs);
                        if (wc == 0) {
#pragma unroll
                            for (int j = 0; j < 8; ++j) { const float o = __shfl_xor(v[j], 32); v[j] = (fq < 2) ? (v[j] * cs[j] - o * sn[j]) : (v[j] * cs[j] + o * sn[j]); } }
                        *(u32x4*)(proj + (size_t)row * NPROJ + EPI_COL(bj)) = pack8(v); } }
        } else if (PART == 1 && pn < 28) {
#pragma unroll
            for (int ai = 0; ai < 2; ++ai)
#pragma unroll
                for (int m = 0; m < 4; ++m) { const int row = EPI_ROW(ai, m); const float rs = rstd_x[row] * asc; const int b = row >> 11, s = row & 2047;
#pragma unroll
                    for (int bj = 0; bj < 2; ++bj) { float v[8]; EPI_LOAD8(v, ai, bj, m, rs); const u32x4 w = pack8(v);
                        *(u32x4*)(proj + (size_t)row * NPROJ + EPI_COL(bj)) = w;
                        const int cc = (pn - 26) * 256 + bj * 128 + wc * 32 + 8 * fq; bf16_t* tp = vT + ((size_t)(b * 512 + cc)) * 2048 + s;
                        tp[0] = (bf16_t)(w.x & 0xffffu); tp[2048] = (bf16_t)(w.x >> 16); tp[2 * 2048] = (bf16_t)(w.y & 0xffffu); tp[3 * 2048] = (bf16_t)(w.y >> 16);
                        tp[4 * 2048] = (bf16_t)(w.z & 0xffffu); tp[5 * 2048] = (bf16_t)(w.z >> 16); tp[6 * 2048] = (bf16_t)(w.w & 0xffffu); tp[7 * 2048] = (bf16_t)(w.w >> 16); } }
        } else if (PART == 0) {
#pragma unroll
            for (int ai = 0; ai < 2; ++ai)
#pragma unroll
                for (int m = 0; m < 4; ++m) { const int row = EPI_ROW(ai, m); const float rs = rstd_x[row] * asc;
                    const f32x4 c0 = *(const f32x4*)(rope_i + (size_t)row * 16), c1 = *(const f32x4*)(rope_i + (size_t)row * 16 + 4), s0 = *(const f32x4*)(rope_i + (size_t)row * 16 + 8), s1 = *(const f32x4*)(rope_i + (size_t)row * 16 + 12);
                    const float cs[8] = {c0[0], c0[1], c0[2], c0[3], c1[0], c1[1], c1[2], c1[3]}, sn[8] = {s0[0], s0[1], s0[2], s0[3], s1[0], s1[1], s1[2], s1[3]};
#pragma unroll
                    for (int bj = 0; bj < 2; ++bj) { float v[8]; EPI_LOAD8(v, ai, bj, m, rs);
                        const bool rot = (pn < 32) ? ((wc & 1) == 0) : (bj == 0 && wc == 0);
                        if (rot) {
#pragma unroll
                            for (int j = 0; j < 8; ++j) { const float o = __shfl_xor(v[j], 16); v[j] = (fq == 0) ? (v[j] * cs[j] - o * sn[j]) : ((fq == 1) ? (v[j] * cs[j] + o * sn[j]) : v[j]); } }
                        *(u32x4*)(proj + (size_t)row * NPROJ + pn * 256 + bj * 128 + wc * 32 + 8 * fq) = pack8(v);   } }
        } else {
            const bool isa = u.pn >= 200; const int gt = isa ? u.pn - 200 : u.pn - 100; bf16_t* gp = proj + (isa ? C_GA : C_GB) + gt * 256;
#pragma unroll
            for (int ai = 0; ai < 2; ++ai)
#pragma unroll
                for (int m = 0; m < 4; ++m) { const int row = EPI_ROW(ai, m); const float rs = rstd_x[row] * asc;
#pragma unroll
                    for (int bj = 0; bj < 2; ++bj) { float v[8]; EPI_LOAD8(v, ai, bj, m, rs);
#pragma unroll
                        for (int j = 0; j < 8; ++j) { const float g = sigmoidf_(v[j]); v[j] = isa ? g : fmaxf(g, 1.0e-20f); }
                        *(u32x4*)(gp + (size_t)row * NPROJ + bj * 128 + wc * 32 + 8 * fq) = pack8(v); } }
        }
        }
    }
};
struct EpiMerge {
    static constexpr bool CONT = true;
    bf16_t* mrg; const bf16_t* proj;
    __device__ __forceinline__ void mid(f32x4 (&acc)[2][2][4][2], const Unit& u, int wr, int wc, int fr, int fq) const {
#pragma unroll
        for (int ai = 0; ai < 2; ++ai) { u32x4 ga[4][2], gb[4][2];
#pragma unroll
            for (int m = 0; m < 4; ++m) { const int row = EPI_ROW(ai, m);
#pragma unroll
                for (int bj = 0; bj < 2; ++bj) { ga[m][bj] = *(const u32x4*)(proj + (size_t)row * NPROJ + C_GA + EPI_COL(bj)); gb[m][bj] = *(const u32x4*)(proj + (size_t)row * NPROJ + C_GB + EPI_COL(bj)); } }
#pragma unroll
            for (int m = 0; m < 4; ++m)
#pragma unroll
                for (int bj = 0; bj < 2; ++bj) { float g[8], h[8]; unpack8(ga[m][bj], g); unpack8(gb[m][bj], h);
#pragma unroll
                    for (int j = 0; j < 8; ++j) g[j] *= F8_SYP * __builtin_amdgcn_rcpf(h[j]);
                    acc[ai][bj][m][0] *= (f32x4){g[0], g[1], g[2], g[3]}; acc[ai][bj][m][1] *= (f32x4){g[4], g[5], g[6], g[7]};
                    asm volatile("" : "+v"(acc[ai][bj][m][0]), "+v"(acc[ai][bj][m][1])); } }
    }
    __device__ __forceinline__ void operator()(const f32x4 (&acc)[2][2][4][2], const Unit& u, int wr, int wc, int fr, int fq) const {
#pragma unroll
        for (int ai = 0; ai < 2; ++ai)
#pragma unroll
            for (int m = 0; m < 4; ++m) { const int row = EPI_ROW(ai, m);
#pragma unroll
                for (int bj = 0; bj < 2; ++bj) { const int c0 = EPI_COL(bj); float v[8], g[8]; EPI_LOAD8(v, ai, bj, m, F8_IYP);
                    unpack8(*(const u32x4*)(proj + (size_t)row * NPROJ + C_GB + c0), g);
#pragma unroll
                    for (int j = 0; j < 8; ++j) v[j] *= g[j];
                    *(u32x4*)(mrg + (size_t)row * DM + c0) = pack8(v); } }
    }
};
template <bool IN_F32>
struct EpiResid {
    static constexpr bool CONT = false;
    const void* xi; bf16_t* xb; float* ssq;
    __device__ __forceinline__ void operator()(const f32x4 (&acc)[2][2][4][2], const Unit& u, int wr, int wc, int fr, int fq) const {
#pragma unroll
        for (int ai = 0; ai < 2; ++ai)
#pragma unroll
            for (int m = 0; m < 4; ++m) { const int row = EPI_ROW(ai, m); float ss = 0.f;
#pragma unroll
                for (int bj = 0; bj < 2; ++bj) { const int c0 = EPI_COL(bj); const size_t off = (size_t)row * DM + c0; float r[8];
                    if (IN_F32) { const f32x4 r0 = *(const f32x4*)((const float*)xi + off), r1 = *(const f32x4*)((const float*)xi + off + 4); r[0] = r0[0]; r[1] = r0[1]; r[2] = r0[2]; r[3] = r0[3]; r[4] = r1[0]; r[5] = r1[1]; r[6] = r1[2]; r[7] = r1[3]; }
                    else unpack8(*(const u32x4*)((const bf16_t*)xi + off), r);
                    const f32x4 a0 = acc[ai][bj][m][0], a1 = acc[ai][bj][m][1];
                    r[0] += a0[0]; r[1] += a0[1]; r[2] += a0[2]; r[3] += a0[3]; r[4] += a1[0]; r[5] += a1[1]; r[6] += a1[2]; r[7] += a1[3];
                    ss += (r[0] * r[0] + r[1] * r[1]) + (r[2] * r[2] + r[3] * r[3]) + (r[4] * r[4] + r[5] * r[5]) + (r[6] * r[6] + r[7] * r[7]);
                    *(u32x4*)(xb + off) = pack8(r); }
                ss += __shfl_xor(ss, 16); ss += __shfl_xor(ss, 32); if (fq == 0) atomicAdd(ssq + row, ss); }
    }
};
struct EpiQx {
    static constexpr bool CONT = false;
    bf16_t* q0; bf16_t* q1; const float* ssq1;
    __device__ __forceinline__ void operator()(const f32x4 (&acc)[2][2][4][2], const Unit& u, int wr, int wc, int fr, int fq) const {
        bf16_t* q = u.kind ? q1 : q0;
#pragma unroll
        for (int ai = 0; ai < 2; ++ai)
#pragma unroll
            for (int m = 0; m < 4; ++m) { const int row = EPI_ROW(ai, m); const float rs = 0.0625f * __builtin_amdgcn_rsqf(ssq1[row] * (1.f / DM) + EPS);
#pragma unroll
                for (int bj = 0; bj < 2; ++bj) { float v[8]; EPI_LOAD8(v, ai, bj, m, rs); *(u32x4*)(q + (size_t)row * 1024 + EPI_COL(bj)) = pack8(v); } }
    }
};
struct EpiFfnUp {
    static constexpr bool CONT = false;
    bf16_t* hdn; const float* ssq2;
    __device__ __forceinline__ void operator()(const f32x4 (&acc)[2][2][4][2], const Unit& u, int wr, int wc, int fr, int fq) const {
#pragma unroll
        for (int ai = 0; ai < 2; ++ai)
#pragma unroll
            for (int m = 0; m < 4; ++m) { const int row = EPI_ROW(ai, m); const float rs = __builtin_amdgcn_rsqf(ssq2[row] * (1.f / DM) + EPS);
                float g[8], w[8]; EPI_LOAD8(g, ai, 0, m, rs); EPI_LOAD8(w, ai, 1, m, rs);
#pragma unroll
                for (int j = 0; j < 8; ++j) g[j] = g[j] * sigmoidf_(g[j]) * w[j];
                *(u32x4*)(hdn + (size_t)row * FFN + u.pn * 128 + wc * 32 + 8 * fq) = pack8(g); }
    }
};

struct SchedZa { int G, c; const char *xb, *win;
    __device__ __forceinline__ bool next(int i, Unit& u) const { const int L = i * G + c; if (L >= 672) return false; const size_t ts = (size_t)256 * DM * 2;
        pg8::tile_of(L, 32, 21, u.pm, u.pn); u.kind = 0; u.A = xb + u.pm * ts; u.B = win + u.pn * ts; return true; } };
struct SchedF8 { int G, c, skip5, extra; const char *xb8, *win8;
    __device__ __forceinline__ bool next(int i, Unit& u) const { int L = i * G + c;
        if (skip5) { if (i >= 5) return false; } else if (extra >= 0 && i == 6) L = 5 * G + extra; else if (L >= 1408) return false;
        const size_t ts = (size_t)256 * DM;
        int pn8; pg8::tile_of(L, 32, 44, u.pm, pn8); u.pn = pn8 < 12 ? 16 + pn8 : (pn8 < 28 ? 200 + (pn8 - 12) : 100 + (pn8 - 28)); u.kind = 0; u.A = xb8 + u.pm * ts; u.B = win8 + pn8 * ts; return true; } };
struct SchedKV { int G, c; const char *memb, *wk, *wv;
    __device__ __forceinline__ bool next(int i, Unit& u) const { const int j = i * G + c; if (j >= 32) return false; const size_t ts = (size_t)256 * DM * 2; const int t = j & 15;
        u.kind = 1 + (j >> 4); u.pm = t >> 2; u.pn = t & 3;
        if (u.kind == 1) { u.A = memb + u.pm * ts; u.B = wk + u.pn * ts; } else { u.A = wv + u.pm * ts; u.B = memb + u.pn * ts; } return true; } };
struct SchedOne { Unit u0;
    __device__ __forceinline__ bool next(int i, Unit& u) const { if (i) return false; u = u0; return true; } };
struct SchedSimple { int G, c, nM, nN; const char *A, *B; size_t tsA, tsB;
    __device__ __forceinline__ bool next(int i, Unit& u) const { const int L = i * G + c; if (L >= nM * nN) return false; pg8::tile_of(L, nM, nN, u.pm, u.pn); u.kind = 0;
        u.A = A + u.pm * tsA; u.B = B + u.pn * tsB; return true; } };
struct SchedG6 { int G, c; const char *x1b, *wq;
    __device__ __forceinline__ bool next(int i, Unit& u) const { const int L = i * G + c; if (L >= 256) return false; pg8::tile_of(L & 127, 32, 4, u.pm, u.pn); u.kind = L >> 7;
        const size_t ts = (size_t)256 * DM * 2; u.A = x1b + u.pm * ts + (u.kind ? 2048 * 2 : 0); u.B = wq + u.pn * ts + (u.kind ? 2048 * 2 : 0); return true; } };

#ifndef CVT_KTB
#define CVT_KTB 128
#endif
#ifndef CVT_KT8
#define CVT_KT8 256
#endif
constexpr int KTB = CVT_KTB, KT8 = CVT_KT8, CVT_SCR = 17408;
template <bool NT_ST, class Src>
__device__ __forceinline__ void cvt_tile(const float* __restrict__ W, int K, int N, const float* __restrict__ gain, bf16_t* __restrict__ WT, LAS unsigned char* scr, int k0, int n0, int lane, Src src) {
    constexpr int PITCH = KTB * 2 + 16, LPR = KTB / 8;
    const int g = lane >> 4, c = lane & 15, sc = src(n0 + 4 * c);
#pragma unroll
    for (int p = 0; p < KTB / 64; ++p) { const int kk = k0 + 64 * p;
        f32x4 v[16];
        if (sc >= 0) { const float* wp = W + (size_t)(kk + 16 * g) * N + sc;
#pragma unroll
            for (int i = 0; i < 16; ++i) v[i] = __builtin_nontemporal_load((const f32x4*)(wp + (size_t)i * N)); }
        else {
#pragma unroll
            for (int i = 0; i < 16; ++i) v[i] = (f32x4){0.f, 0.f, 0.f, 0.f}; }
        if (gain) {
#pragma unroll
            for (int q = 0; q < 4; ++q) { const f32x4 gq = *(const f32x4*)(gain + kk + 16 * g + 4 * q); v[4 * q] *= gq[0]; v[4 * q + 1] *= gq[1]; v[4 * q + 2] *= gq[2]; v[4 * q + 3] *= gq[3]; } }
#pragma unroll
        for (int j = 0; j < 4; ++j) { u32x4 a, b2;
            a.x = pk2(v[0][j], v[1][j]); a.y = pk2(v[2][j], v[3][j]); a.z = pk2(v[4][j], v[5][j]); a.w = pk2(v[6][j], v[7][j]);
            b2.x = pk2(v[8][j], v[9][j]); b2.y = pk2(v[10][j], v[11][j]); b2.z = pk2(v[12][j], v[13][j]); b2.w = pk2(v[14][j], v[15][j]);
            LAS unsigned char* sp = scr + (4 * c + j) * PITCH + 128 * p + 32 * g; *(LAS u32x4*)sp = a; *(LAS u32x4*)(sp + 16) = b2; } }
    LDS_WAIT(); asm volatile("" ::: "memory");
#pragma unroll
    for (int r = 0; r < LPR; ++r) { const int row = (64 / LPR) * r + lane / LPR, ch = lane % LPR; const u32x4 o = *(const LAS u32x4*)(scr + row * PITCH + 16 * ch);
        u32x4* dp = (u32x4*)(WT + (size_t)(n0 + row) * K + k0 + 8 * ch); if (NT_ST) __builtin_nontemporal_store(o, dp); else *dp = o; }
    LDS_WAIT(); asm volatile("" ::: "memory");
}
template <class Src>
__device__ __forceinline__ void cvt_tile8(const float* __restrict__ W, int K, int N, const float* __restrict__ gain, float scale, unsigned char* __restrict__ WT8, LAS unsigned char* scr, int k0, int n0, int n0dst, int lane, Src src) {
    constexpr int PITCH = KT8 + 16, LPR = KT8 / 16;
    const int g = lane >> 4, c = lane & 15, sc = src(n0 + 4 * c);
#pragma unroll
    for (int p = 0; p < KT8 / 64; ++p) { const int kk = k0 + 64 * p;
        f32x4 v[16];
        if (sc >= 0) { const float* wp = W + (size_t)(kk + 16 * g) * N + sc;
#pragma unroll
            for (int i = 0; i < 16; ++i) v[i] = __builtin_nontemporal_load((const f32x4*)(wp + (size_t)i * N)); }
        else {
#pragma unroll
            for (int i = 0; i < 16; ++i) v[i] = (f32x4){0.f, 0.f, 0.f, 0.f}; }
#pragma unroll
        for (int q = 0; q < 4; ++q) { f32x4 gq = gain ? *(const f32x4*)(gain + kk + 16 * g + 4 * q) : (f32x4){1.f, 1.f, 1.f, 1.f}; gq *= scale; v[4 * q] *= gq[0]; v[4 * q + 1] *= gq[1]; v[4 * q + 2] *= gq[2]; v[4 * q + 3] *= gq[3]; }
#pragma unroll
        for (int j = 0; j < 4; ++j) { u32x4 a;
            a.x = pk4_fp8(v[0][j], v[1][j], v[2][j], v[3][j]); a.y = pk4_fp8(v[4][j], v[5][j], v[6][j], v[7][j]); a.z = pk4_fp8(v[8][j], v[9][j], v[10][j], v[11][j]); a.w = pk4_fp8(v[12][j], v[13][j], v[14][j], v[15][j]);
            *(LAS u32x4*)(scr + (4 * c + j) * PITCH + 64 * p + 16 * g) = a; } }
    LDS_WAIT(); asm volatile("" ::: "memory");
#pragma unroll
    for (int r = 0; r < LPR; ++r) { const int row = (64 / LPR) * r + lane / LPR, ch = lane % LPR; const u32x4 o = *(const LAS u32x4*)(scr + row * PITCH + 16 * ch);
        *(u32x4*)(WT8 + (size_t)(n0dst + row) * K + k0 + 16 * ch) = o; }
    LDS_WAIT(); asm volatile("" ::: "memory");
}
struct SrcId { static constexpr bool NTL = true; __device__ __forceinline__ int operator()(int n) const { return n; } };
struct SrcId0 { static constexpr bool NTL = false; __device__ __forceinline__ int operator()(int n) const { return n; } };
struct SrcWinB { static constexpr bool NTL = false; __device__ __forceinline__ int operator()(int n) const { if (n < 4096) return n; if (n < 5200) return 7168 + (n - 4096); return -1; } };
struct SrcWin8 { static constexpr bool NTL = false; __device__ __forceinline__ int operator()(int n) const { return n < 3072 ? 4096 + n : 8272 + (n - 3072); } };
struct Src13 { static constexpr bool NTL = true; __device__ __forceinline__ int operator()(int n) const { return (n >> 8) * 128 + (n & 127); } };
__device__ __forceinline__ void row_to_bf16(const float* xrow, bf16_t* orow, unsigned* o8row, float* rstd, int lane) {
    const f32x4* xr = (const f32x4*)xrow + lane; float s = 0.f; f32x4 v[16];
#pragma unroll
    for (int j = 0; j < 16; ++j) { v[j] = xr[64 * j]; s += (v[j][0] * v[j][0] + v[j][1] * v[j][1]) + (v[j][2] * v[j][2] + v[j][3] * v[j][3]); }
    s = wave_sum(s);
    if (lane == 0) *rstd = 1.0f / sqrtf(s * (1.f / DM) + EPS);
    u32x2* o8 = (u32x2*)orow + lane;
#pragma unroll
    for (int j = 0; j < 16; ++j) { u32x2 w; w.x = pk2(v[j][0], v[j][1]); w.y = pk2(v[j][2], v[j][3]); o8[64 * j] = w; }
    if (o8row) {
#pragma unroll
        for (int j = 0; j < 16; ++j) o8row[64 * j + lane] = pk4_fp8(v[j][0] * F8_SA, v[j][1] * F8_SA, v[j][2] * F8_SA, v[j][3] * F8_SA); }
}
struct CvtItem { const float* wp; const float* gp; unsigned char* dst; int N, K; float scale; int f8, nts; };
constexpr int CW_BUF = 69632, CW_PB = 272, CW_P8 = 144;
template <class Src>
__device__ __forceinline__ void cw_fill(CvtItem& it, const float* W, int K, int N, const float* gain, float scale, unsigned char* dst, int eb, int kb, int nb, int wave, int lane, Src src) {
    const int k0 = kb * 128, n0 = nb * 256, sc = src(n0 + 4 * lane);
    it.wp = sc >= 0 ? W + (size_t)(k0 + 16 * wave) * N + sc : nullptr; it.gp = gain ? gain + k0 + 16 * wave : nullptr; it.dst = dst + ((size_t)n0 * K + k0) * eb; it.N = N; it.K = K; it.scale = scale; it.f8 = (eb == 1); it.nts = Src::NTL;
}
__device__ __forceinline__ void cw_load(const CvtItem& it, f32x4 (&v)[16]) {
    if (it.wp) {
#pragma unroll
        for (int i = 0; i < 16; ++i) v[i] = __builtin_nontemporal_load((const f32x4*)(it.wp + (size_t)i * it.N)); }
    else {
#pragma unroll
        for (int i = 0; i < 16; ++i) v[i] = (f32x4){0.f, 0.f, 0.f, 0.f}; }
}
__device__ __forceinline__ void cw_to_lds(const CvtItem& it, f32x4 (&v)[16], LAS unsigned char* buf, int wave, int lane) {
#pragma unroll
    for (int i = 0; i < 16; ++i) { const float g = (it.gp ? it.gp[i] : 1.f) * it.scale; v[i] *= g; }
    if (it.f8) {
#pragma unroll
        for (int j = 0; j < 4; ++j) { u32x4 a;
            a.x = pk4_fp8(v[0][j], v[1][j], v[2][j], v[3][j]); a.y = pk4_fp8(v[4][j], v[5][j], v[6][j], v[7][j]); a.z = pk4_fp8(v[8][j], v[9][j], v[10][j], v[11][j]); a.w = pk4_fp8(v[12][j], v[13][j], v[14][j], v[15][j]);
            *(LAS u32x4*)(buf + (4 * lane + j) * CW_P8 + 16 * wave) = a; } }
    else {
#pragma unroll
        for (int j = 0; j < 4; ++j) { u32x4 a, b2;
            a.x = pk2(v[0][j], v[1][j]); a.y = pk2(v[2][j], v[3][j]); a.z = pk2(v[4][j], v[5][j]); a.w = pk2(v[6][j], v[7][j]);
            b2.x = pk2(v[8][j], v[9][j]); b2.y = pk2(v[10][j], v[11][j]); b2.z = pk2(v[12][j], v[13][j]); b2.w = pk2(v[14][j], v[15][j]);
            LAS unsigned char* sp = buf + (4 * lane + j) * CW_PB + 32 * wave; *(LAS u32x4*)sp = a; *(LAS u32x4*)(sp + 16) = b2; } }
}
__device__ __forceinline__ void cw_store(const CvtItem& it, LAS unsigned char* buf, int tid) {
    if (it.f8) {
#pragma unroll
        for (int rr = 0; rr < 4; ++rr) { const int row = 64 * rr + (tid >> 3), ch = tid & 7; const u32x4 o = *(const LAS u32x4*)(buf + row * CW_P8 + 16 * ch);
            u32x4* dp = (u32x4*)(it.dst + (size_t)row * it.K + 16 * ch); if (it.nts) __builtin_nontemporal_store(o, dp); else *dp = o; } }
    else {
#pragma unroll
        for (int rr = 0; rr < 8; ++rr) { const int row = 32 * rr + (tid >> 4), ch = tid & 15; const u32x4 o = *(const LAS u32x4*)(buf + row * CW_PB + 16 * ch);
            u32x4* dp = (u32x4*)(it.dst + (size_t)row * it.K * 2 + 16 * ch); if (it.nts) __builtin_nontemporal_store(o, dp); else *dp = o; } }
}
template <class Get>
__device__ __forceinline__ void cw_run(Frame& F, int first, int step, int end, Get get) {
    if (first >= end) return;
    int tz = F.tid; asm volatile("" : "+v"(tz));
    const int wave = F.wave, lane = tz & 63;
    CvtItem c0, c1, st; f32x4 v0[16], v1[16];
    get(first, wave, lane, c0); cw_load(c0, v0); c1 = c0;
    if (first + step < end) { get(first + step, wave, lane, c1); cw_load(c1, v1); }
    __syncthreads();
    for (int r = first; r < end; r += 2 * step) {
        cw_to_lds(c0, v0, F.lds, wave, lane); st = c0;
        if (r + 2 * step < end) { get(r + 2 * step, wave, lane, c0); cw_load(c0, v0); }
        __syncthreads();
        cw_store(st, F.lds, tz);
        if (r + step >= end) break;
        cw_to_lds(c1, v1, F.lds + CW_BUF, wave, lane); st = c1;
        if (r + 3 * step < end) { get(r + 3 * step, wave, lane, c1); cw_load(c1, v1); }
        __syncthreads();
        cw_store(st, F.lds + CW_BUF, tz);
    }
    __syncthreads();
}
constexpr int CW_WINB = 32 * 21, CW_WIN8 = 32 * 44, CW_XQ = 32 * 4, CW_XO = 8 * 16, CW_N0 = CW_WINB + CW_WIN8 + 3 * CW_XQ + CW_XO;
constexpr int CW_WOUT = 32 * 16, CW_PB8 = 16 * 16, CW_PA = 16 * 16, CW_W2 = (FFN / 128) * 16, CW_W13 = 32 * (N13 / 256), CW_NL = CW_WOUT + CW_PB8 + CW_PA + CW_W2 + CW_W13;
__device__ __forceinline__ void cw_item_p0(const Params& P, unsigned char* ws, int r, int wave, int lane, CvtItem& it) {
    if (r < CW_WINB) { cw_fill(it, P.w_in, DM, 16464, P.norm_mix_g, 1.f, ws + WS_WIN, 2, r / 21, r % 21, wave, lane, SrcWinB()); return; } r -= CW_WINB;
    if (r < CW_WIN8) { cw_fill(it, P.w_in, DM, 16464, P.norm_mix_g, F8_SB, ws + WS_WIN8, 1, r / 44, r % 44, wave, lane, SrcWin8()); return; } r -= CW_WIN8;
    if (r < CW_XQ) { cw_fill(it, P.xq, DM, 1024, P.norm_x_g, 1.f, ws + WS_WQ, 2, r / 4, r % 4, wave, lane, SrcId()); return; } r -= CW_XQ;
    if (r < CW_XQ) { cw_fill(it, P.xk, DM, 1024, P.norm_mem_g, 1.f, ws + WS_WK, 2, r / 4, r % 4, wave, lane, SrcId0()); return; } r -= CW_XQ;
    if (r < CW_XQ) { cw_fill(it, P.xv, DM, 1024, P.norm_mem_g, 1.f, ws + WS_WV, 2, r / 4, r % 4, wave, lane, SrcId0()); return; } r -= CW_XQ;
    cw_fill(it, P.xo, 1024, DM, nullptr, 1.f, ws + WS_WO, 2, r / 16, r % 16, wave, lane, SrcId());
}
__device__ __forceinline__ void cw_item_late(const Params& P, unsigned char* ws, int r, int wave, int lane, CvtItem& it) {
    if (r < CW_WOUT) { cw_fill(it, P.w_out, DM, DM, nullptr, 1.f, ws + WS_WOUT, 2, r / 16, r % 16, wave, lane, SrcId()); return; } r -= CW_WOUT;
    if (r < CW_PB8) { cw_fill(it, P.p_b, 2048, DM, nullptr, F8_SPB, ws + WS_PB, 1, r / 16, r % 16, wave, lane, SrcId()); return; } r -= CW_PB8;
    if (r < CW_PA) { cw_fill(it, P.p_a, 2048, DM, nullptr, 1.f, ws + WS_PA, 2, r / 16, r % 16, wave, lane, SrcId()); return; } r -= CW_PA;
    if (r < CW_W2) { cw_fill(it, P.w2, FFN, DM, nullptr, 1.f, ws + WS_W2, 2, r / 16, r % 16, wave, lane, SrcId()); return; } r -= CW_W2;
    { const int nb = r % (N13 / 256); const float* W = (((nb * 256 + 4 * lane) >> 7) & 1) ? P.w3 : P.w1; cw_fill(it, W, DM, FFN, P.norm_ffn_g, 1.f, ws + WS_W13, 2, r / (N13 / 256), nb, wave, lane, Src13()); }
}
#ifndef N_FREE_WG
#define N_FREE_WG 40
#endif
#ifndef P0_MID
#define P0_MID 0
#endif
#ifndef P0_W2_PCT
#define P0_W2_PCT 0
#endif
constexpr int I_WINB = (DM / KTB) * 84, I_WIN8 = (DM / KT8) * 176, I_PB = (2048 / KT8) * 64, I_PA = (2048 / KTB) * 64, I_WOUT = (DM / KTB) * 64, I_XQ = (DM / KTB) * 16, I_XO = (1024 / KTB) * 64, I_2 = (FFN / KTB) * 64, I_13 = (DM / KTB) * (N13 / 64);
constexpr int N_MIDLATE = I_PB + I_PA + I_WOUT + I_2 + I_13;
constexpr int N_MID_EARLY = P0_MID * (I_PB + I_PA + I_WOUT) + (I_2 * P0_W2_PCT) / 100;
__device__ __forceinline__ void midlate_item(const Params& P, unsigned char* ws, LAS unsigned char* scr, int r, int lane) {
    if (r < I_WOUT) { cvt_tile<true>(P.w_out, DM, DM, nullptr, (bf16_t*)(ws + WS_WOUT), scr, KTB * (r / 64), 64 * (r % 64), lane, SrcId()); return; } r -= I_WOUT;
    if (r < I_PB) { cvt_tile8(P.p_b, 2048, DM, nullptr, F8_SPB, ws + WS_PB, scr, KT8 * (r / 64), 64 * (r % 64), 64 * (r % 64), lane, SrcId()); return; } r -= I_PB;
    if (r < I_PA) { cvt_tile<true>(P.p_a, 2048, DM, nullptr, (bf16_t*)(ws + WS_PA), scr, KTB * (r / 64), 64 * (r % 64), lane, SrcId()); return; } r -= I_PA;
    if (r < I_2) { cvt_tile<true>(P.w2, FFN, DM, nullptr, (bf16_t*)(ws + WS_W2), scr, KTB * (r / 64), 64 * (r % 64), lane, SrcId()); return; } r -= I_2;
    { const int nb = N13 / 64, n0 = 64 * (r % nb); cvt_tile<true>(((n0 >> 7) & 1) ? P.w3 : P.w1, DM, FFN, P.norm_ffn_g, (bf16_t*)(ws + WS_W13), scr, KTB * (r / nb), n0, lane, Src13()); }
}
__device__ __forceinline__ void p0_prologue(Frame& F, const Params& P, const bool with_late) {
    LAS unsigned char* scr = F.lds + F.wave * CVT_SCR;
    const int gw = F.bid * 8 + F.wave, NGW = F.G * 8, lane = F.lane;
    unsigned char* ws = F.ws;
    cw_run(F, F.bid, F.G, CW_N0, [&](int r, int wv, int ln, CvtItem& it) { cw_item_p0(P, ws, r, wv, ln, it); });
    if (with_late) cw_run(F, F.bid, F.G, CW_NL, [&](int r, int wv, int ln, CvtItem& it) { cw_item_late(P, ws, r, wv, ln, it); });
    for (int m = gw; m < M; m += NGW) row_to_bf16(P.x + (size_t)m * DM, (bf16_t*)(ws + WS_XB) + (size_t)m * DM, (unsigned*)(ws + WS_XB8) + (size_t)m * (DM / 4), F_RSTDX + m, lane);
    for (int m = gw; m < MEMR; m += NGW) row_to_bf16(P.mem + (size_t)m * DM, (bf16_t*)(ws + WS_MEMB) + (size_t)m * DM, nullptr, F_RSTDM + m, lane);
    const int gt = F.bid * 512 + F.tid, NGT = F.G * 512;
    for (int e = gt; e < M * 24; e += NGT) { const int row = e / 24, i = e % 24; const bool isb = i < 16; const int fi = isb ? i : i - 16;
        const float inv = powf(500000.0f, isb ? -(float)fi / 16.0f : -(float)fi / 8.0f); const float ang = (float)P.pos[row] * inv;
        const double tr = (double)ang * 0.15915494309189535; const float fr = (float)(tr - rint(tr));
        const float cv = __builtin_amdgcn_cosf(fr), sv = __builtin_amdgcn_sinf(fr);
        if (isb) { F_ROPEB[(size_t)row * 32 + fi] = cv; F_ROPEB[(size_t)row * 32 + 16 + fi] = sv; } else { F_ROPEI[(size_t)row * 16 + fi] = cv; F_ROPEI[(size_t)row * 16 + 8 + fi] = sv; } }
    bf16_t* Wc = (bf16_t*)(ws + WS_WC);
    for (int e = gt; e < 16 * 128 * 128; e += NGT) { const int s = e & 127, t = (e >> 7) & 127; Wc[e] = (s <= t) ? (bf16_t)(pk2(P.a_sw[e], 0.f) & 0xffffu) : (bf16_t)0; }
}

__device__ __forceinline__ void convert_late(Frame& F, const Params& P, unsigned* ctr) {
    LAS unsigned char* scr = F.lds + F.wave * CVT_SCR;
    for (;;) {
        unsigned r = 0; if (F.lane == 0) r = atomicAdd(ctr, 1u);
        r = (unsigned)__builtin_amdgcn_readfirstlane((int)r) + (unsigned)N_MID_EARLY;
        if (r >= (unsigned)N_MIDLATE) break;
        midlate_item(P, F.ws, scr, (int)r, F.lane);
    }
}

__device__ __forceinline__ void spatial_unit(Frame& F, const Params& P, int unit) {
    const int g = unit & 15, c = (unit >> 4) & 15, b = unit >> 8, row0 = b * SEQ + c * 128;
    int tz = F.tid; asm volatile("" : "+v"(tz));
    const int wt = F.wave >> 1, wd = F.wave & 1, fr = tz & 15, fq = (tz & 63) >> 4;
    const bf16_t* Wc = (const bf16_t*)(F.ws + WS_WC) + (size_t)g * 128 * 128;
    const bf16_t* vTa = (const bf16_t*)(F.ws + WS_VTA) + ((size_t)(b * 2048 + g * 128 + 64 * wd + fr)) * 2048 + c * 128 + 8 * fq;
    f32x4 acc[2][4];
#pragma unroll
    for (int i = 0; i < 2; ++i)
#pragma unroll
        for (int j = 0; j < 4; ++j) acc[i][j] = (f32x4){0.f, 0.f, 0.f, 0.f};
    u32x2 uw[2][4]; f32x4 gn[4]; float bias[2];
#pragma unroll
    for (int j = 0; j < 4; ++j) gn[j] = *(const f32x4*)(P.a_norm_g + g * 128 + 64 * wd + 16 * j + 4 * fq);
#pragma unroll
    for (int i = 0; i < 2; ++i) { const int t = 32 * wt + 16 * i + fr; bias[i] = P.a_sb[g * 128 + t];
#pragma unroll
        for (int j = 0; j < 4; ++j) uw[i][j] = *(const u32x2*)(F_PROJ + (size_t)(row0 + t) * NPROJ + C_U + g * 128 + 64 * wd + 16 * j + 4 * fq); }
#pragma unroll
    for (int ks = 0; ks < 4; ++ks) {
        if (ks <= wt) {
            const f32x4 q0 = *(const f32x4*)(F_SSQV + row0 + 32 * ks + 8 * fq), q1 = *(const f32x4*)(F_SSQV + row0 + 32 * ks + 8 * fq + 4);
            float rs[8];
#pragma unroll
            for (int e = 0; e < 4; ++e) { rs[e] = __builtin_amdgcn_rsqf(q0[e] * (1.f / 2048.f) + EPS); rs[4 + e] = __builtin_amdgcn_rsqf(q1[e] * (1.f / 2048.f) + EPS); }
            bf16x8 af[2], bg[4];
#pragma unroll
            for (int i = 0; i < 2; ++i) { float wv[8]; unpack8(*(const u32x4*)(Wc + (32 * wt + 16 * i + fr) * 128 + 32 * ks + 8 * fq), wv);
#pragma unroll
                for (int e = 0; e < 8; ++e) wv[e] *= rs[e];
                af[i] = __builtin_bit_cast(bf16x8, pack8(wv)); }
#pragma unroll
            for (int j = 0; j < 4; ++j) bg[j] = *(const bf16x8*)(vTa + (size_t)(16 * j) * 2048 + 32 * ks);
#pragma unroll
            for (int i = 0; i < 2; ++i)
#pragma unroll
                for (int j = 0; j < 4; ++j) acc[i][j] = MFMA16(bg[j], af[i], acc[i][j]);
        }
    }
    bf16_t* Y = F_Y;
#pragma unroll
    for (int i = 0; i < 2; ++i) { const int t = 32 * wt + 16 * i + fr; const float bs = bias[i];
#pragma unroll
        for (int j = 0; j < 4; ++j) { const int d = 64 * wd + 16 * j + 4 * fq; const f32x4 gj = gn[j]; const u32x2 uu = uw[i][j];
            const float y0 = bf_lo(uu.x) * (acc[i][j][0] * gj[0] + bs), y1 = bf_hi(uu.x) * (acc[i][j][1] * gj[1] + bs), y2 = bf_lo(uu.y) * (acc[i][j][2] * gj[2] + bs), y3 = bf_hi(uu.y) * (acc[i][j][3] * gj[3] + bs);
            u32x2 o; o.x = pk2(y0, y1); o.y = pk2(y2, y3); *(u32x2*)(Y + (size_t)(row0 + t) * DM + g * 128 + d) = o; } }
}

__device__ __forceinline__ int wave_isum_dpp(int v) {
    v += __builtin_amdgcn_update_dpp(0, v, 0x111, 0xf, 0xf, true);
    v += __builtin_amdgcn_update_dpp(0, v, 0x112, 0xf, 0xf, true);
    v += __builtin_amdgcn_update_dpp(0, v, 0x114, 0xf, 0xf, true);
    v += __builtin_amdgcn_update_dpp(0, v, 0x118, 0xf, 0xf, true);
    v += __builtin_amdgcn_update_dpp(0, v, 0x142, 0xa, 0xf, false);
    v += __builtin_amdgcn_update_dpp(0, v, 0x143, 0xc, 0xf, false);
    return __builtin_amdgcn_readlane(v, 63);
}
__device__ __forceinline__ void transpose32(unsigned (&a)[32]) {
#pragma unroll
    for (int k = 0; k < 16; ++k) { const unsigned x = a[k], y = a[k + 16]; a[k] = __builtin_amdgcn_perm(y, x, 0x05040100u); a[k + 16] = __builtin_amdgcn_perm(y, x, 0x07060302u); }
#pragma unroll
    for (int k = 0; k < 32; ++k) if (!(k & 8)) { const unsigned x = a[k], y = a[k + 8]; a[k] = __builtin_amdgcn_perm(y, x, 0x06020400u); a[k + 8] = __builtin_amdgcn_perm(y, x, 0x07030501u); }
#pragma unroll
    for (int j = 4; j; j >>= 1) { const unsigned m = j == 4 ? 0x0f0f0f0fu : (j == 2 ? 0x33333333u : 0x55555555u);
#pragma unroll
        for (int k = 0; k < 32; ++k) if (!(k & j)) { const unsigned x = a[k], y = a[k + j]; a[k] = (x & m) | ((y << j) & ~m); a[k + j] = ((x >> j) & m) | (y & ~m); } }
}
__device__ __forceinline__ void sel_planes(const LAS float* sr, int t, int lane, unsigned (&pl)[32]) {
#pragma unroll
    for (int j = 0; j < 32; ++j) { const unsigned bits = __float_as_uint(sr[j]); const unsigned ord = bits ^ ((bits >> 31) ? 0xffffffffu : 0x80000000u); pl[j] = (32 * lane + j <= t) ? ord : 0u; }
    transpose32(pl);
}
__device__ __forceinline__ unsigned sel_finish(unsigned gt, unsigned eq, int need, int ceq, int lane) {
    if (ceq == need) return gt | eq;
    const int myeq = __builtin_popcount(eq); int inc = myeq;
#pragma unroll
    for (int o = 1; o < 64; o <<= 1) { const int v = __shfl_up(inc, o); if (lane >= o) inc += v; }
    int take = need - (inc - myeq); take = take < 0 ? 0 : (take > myeq ? myeq : take);
    unsigned kept = 0u, e = eq; while (take > 0) { const unsigned lo = e & (0u - e); kept |= lo; e ^= lo; --take; }
    return gt | kept;
}
__device__ __forceinline__ void indexer_unit(Frame& F, int b, int tile) {
    int tz = F.tid; asm volatile("" : "+v"(tz));
    const int tok0 = tile * 16, w = F.wave, lane = tz & 63, r = lane & 31, h = lane >> 5;
    LAS float* sc = (LAS float*)F.lds;
    const int tk = tok0 + 2 * w + ((r >> 2) & 1), hd = (r & 3) + 4 * (r >> 3);
    const bf16_t* ap = F_PROJ + (size_t)(b * SEQ + tk) * NPROJ + C_QI + hd * 64 + 8 * h;
    bf16x8 af[4];
#pragma unroll
    for (int s = 0; s < 4; ++s) af[s] = *(const bf16x8*)(ap + 16 * s);
    float wv[16];
    { const bf16_t* wp = F_PROJ + (size_t)(b * SEQ + tok0 + 2 * w + h) * NPROJ + C_WI; float t0[8], t1[8]; unpack8(*(const u32x4*)wp, t0); unpack8(*(const u32x4*)(wp + 8), t1);
#pragma unroll
      for (int j = 0; j < 8; ++j) { wv[j] = t0[j]; wv[8 + j] = t1[j]; } }
    const int nkt = (tok0 + 15) / 32 + 1;
    __syncthreads();
    const bf16_t* kp = F_PROJ + (size_t)(b * SEQ + r) * NPROJ + C_KI + 8 * h;
    bf16x8 kf[4][4];
#pragma unroll
    for (int i = 0; i < 4; ++i) { const bf16_t* kq = kp + (size_t)(i < nkt ? i : nkt - 1) * 32 * NPROJ;
#pragma unroll
        for (int s = 0; s < 4; ++s) kf[i][s] = *(const bf16x8*)(kq + 16 * s); }
    for (int kt = 0; kt < nkt; kt += 4) {
#pragma unroll
        for (int i = 0; i < 4; ++i) {
            if (kt + i < nkt) {
                f32x16 acc;
#pragma unroll
                for (int q = 0; q < 16; ++q) acc[q] = 0.f;
#pragma unroll
                for (int s = 0; s < 4; ++s) acc = MFMA32(af[s], kf[i][s], acc);
                float sco = 0.f;
#pragma unroll
                for (int q = 0; q < 16; ++q) sco += wv[q] * fmaxf(acc[q], 0.f);
                const int key = (kt + i) * 32 + r;
                sc[(2 * w + h) * 2112 + key + (key >> 5)] = sco;
            }
            { const int kn = kt + i + 4; const bf16_t* kq = kp + (size_t)(kn < nkt ? kn : nkt - 1) * 32 * NPROJ;
#pragma unroll
              for (int s = 0; s < 4; ++s) kf[i][s] = *(const bf16x8*)(kq + 16 * s); }
        }
    }
    LDS_WAIT(); asm volatile("" ::: "memory");
    {
        const int tA = tok0 + 2 * w;
        unsigned* mrow = F_MASK + (size_t)(b * SEQ + tA) * 64;
        unsigned wordA, wordB;
        if (tA < 256) {
            const int nA = tA + 1 - 32 * lane, nB = nA + 1;
            wordA = nA >= 32 ? 0xffffffffu : (nA <= 0 ? 0u : ((1u << nA) - 1u)); wordB = nB >= 32 ? 0xffffffffu : (nB <= 0 ? 0u : ((1u << nB) - 1u));
        } else {
            unsigned pa[32], pb[32];
            sel_planes(sc + (2 * w) * 2112 + 33 * lane, tA, lane, pa); sel_planes(sc + (2 * w + 1) * 2112 + 33 * lane, tA + 1, lane, pb);
            unsigned alA = 0xffffffffu, alB = 0xffffffffu, gtA = 0u, gtB = 0u; int abA = 0, abB = 0; bool dA = false, dB = false;
#pragma unroll
            for (int bit = 31; bit >= 0; --bit) {
                if (dA && dB) break;
                const unsigned mA = alA & pa[bit], mB = alB & pb[bit];
                const int tot = wave_isum_dpp(__builtin_popcount(mA) | (__builtin_popcount(mB) << 16));
                const int cA = tot & 0xffff, cB = tot >> 16;
                if (!dA) { if (abA + cA >= 256) { alA = mA; dA = (abA + cA == 256); } else { abA += cA; gtA |= mA; alA &= ~pa[bit]; } }
                if (!dB) { if (abB + cB >= 256) { alB = mB; dB = (abB + cB == 256); } else { abB += cB; gtB |= mB; alB &= ~pb[bit]; } }
            }
            const int tote = wave_isum_dpp(__builtin_popcount(alA) | (__builtin_popcount(alB) << 16));
            wordA = sel_finish(gtA, alA, 256 - abA, tote & 0xffff, lane); wordB = sel_finish(gtB, alB, 256 - abB, tote >> 16, lane);
        }
        mrow[lane] = wordA; mrow[64 + lane] = wordB;
    }
}
__device__ __forceinline__ void attn_unit(Frame& F, int b, int kvh, int qt) {
    constexpr int KP = 272, VP = 144, BUF = 64 * KP + 128 * VP;
    LAS unsigned* mk = (LAS unsigned*)(F.lds + 2 * BUF);
    int tz = F.tid; asm volatile("" : "+v"(tz));
    const int T0 = qt * 64, w = F.wave, lane = tz & 63, q = lane & 31, h = lane >> 5, tg = w >> 2, hq = kvh * 4 + (w & 3);
    const size_t rowq = (size_t)(b * SEQ + T0 + 32 * tg + q);
    bf16x8 qf[8];
    { const bf16_t* qp = F_PROJ + rowq * NPROJ + C_Q + hq * 128 + 8 * h;
#pragma unroll
      for (int ds = 0; ds < 8; ++ds) qf[ds] = *(const bf16x8*)(qp + 16 * ds); }
    const bf16_t* kg = F_PROJ + (size_t)(b * SEQ + (tz >> 4)) * NPROJ + C_K + kvh * 128 + (tz & 15) * 8;
    const bf16_t* vg = F_VT + (size_t)(b * 512 + kvh * 128 + (tz >> 3)) * 2048 + (tz & 7) * 8;
    const int kl = (tz >> 4) * KP + (tz & 15) * 16, vl = 64 * KP + (tz >> 3) * VP + ((tz & 7) >> 1) * 32 + (tz & 1) * 8;
    u32x4 pk0, pk1, pv0, pv1;
    pk0 = *(const u32x4*)kg; pk1 = *(const u32x4*)(kg + (size_t)32 * NPROJ); pv0 = *(const u32x4*)vg; pv1 = *(const u32x4*)(vg + (size_t)64 * 2048);
    __syncthreads();
    for (int i = tz; i < 64 * 64; i += 512) { const int rr = i >> 6, cc = i & 63; mk[rr * 65 + cc] = F_MASK[(size_t)(b * SEQ + T0 + rr) * 64 + cc]; }
    *(LAS u32x4*)(F.lds + kl) = pk0; *(LAS u32x4*)(F.lds + kl + 32 * KP) = pk1; *(LAS u32x2*)(F.lds + vl) = (u32x2){pv0.x, pv0.y}; *(LAS u32x2*)(F.lds + vl + 16) = (u32x2){pv0.z, pv0.w}; *(LAS u32x2*)(F.lds + vl + 64 * VP) = (u32x2){pv1.x, pv1.y}; *(LAS u32x2*)(F.lds + vl + 64 * VP + 16) = (u32x2){pv1.z, pv1.w};
    __syncthreads();
    f32x16 o[4];
#pragma unroll
    for (int dt = 0; dt < 4; ++dt)
#pragma unroll
        for (int i = 0; i < 16; ++i) o[dt][i] = 0.f;
    const float NEG = -1.0e30f, cl = 0.08838834764831845f * 1.4426950408889634f;
    float mrun = NEG, lrun = 0.f;
    const int nkt = qt + 1;
    for (int kt = 0; kt < nkt; ++kt) {
        LAS unsigned char* ldsK = F.lds + (kt & 1) * BUF; LAS unsigned char* ldsV = ldsK + 64 * KP;
        const bool more = kt + 1 < nkt;
        if (more) { const bf16_t* kn = kg + (size_t)(kt + 1) * 64 * NPROJ; const bf16_t* vn = vg + (kt + 1) * 64;
            pk0 = *(const u32x4*)kn; pk1 = *(const u32x4*)(kn + (size_t)32 * NPROJ); pv0 = *(const u32x4*)vn; pv1 = *(const u32x4*)(vn + (size_t)64 * 2048); }
#pragma unroll
        for (int hf = 0; hf < 2; ++hf) {
            f32x16 sv;
#pragma unroll
            for (int i = 0; i < 16; ++i) sv[i] = 0.f;
#pragma unroll
            for (int ds = 0; ds < 8; ++ds) { const bf16x8 kf = *(const LAS bf16x8*)(ldsK + (q + 32 * hf) * KP + (16 * ds + 8 * h) * 2); sv = MFMA32(kf, qf[ds], sv); }
            const unsigned wm = mk[(32 * tg + q) * 65 + 2 * kt + hf] >> (4 * h);
            float tmax = NEG;
#pragma unroll
            for (int i = 0; i < 16; ++i) { const int pos = (i & 3) + 8 * (i >> 2); const int sel = __builtin_amdgcn_sbfe((int)wm, pos, 1); sv[i] = __int_as_float((sel & __float_as_int(sv[i])) | (~sel & __float_as_int(NEG))); tmax = fmaxf(tmax, sv[i]); }
            tmax = xmax32(tmax);
            if (!__all((tmax - mrun) * cl <= 8.0f)) {
                const float mnew = fmaxf(mrun, tmax), alpha = __builtin_amdgcn_exp2f((mrun - mnew) * cl); mrun = mnew; lrun *= alpha;
#pragma unroll
                for (int dt = 0; dt < 4; ++dt)
#pragma unroll
                    for (int i = 0; i < 16; ++i) o[dt][i] *= alpha; }
            const float mc = mrun * cl;
            float ps = 0.f;
#pragma unroll
            for (int i = 0; i < 16; ++i) { sv[i] = __builtin_amdgcn_exp2f(sv[i] * cl - mc); ps += sv[i]; }
            lrun += ps;
            bf16x8 pf[2];
#pragma unroll
            for (int s2 = 0; s2 < 2; ++s2) { u32x4 a; a.x = pk2(sv[8 * s2], sv[8 * s2 + 1]); a.y = pk2(sv[8 * s2 + 2], sv[8 * s2 + 3]); a.z = pk2(sv[8 * s2 + 4], sv[8 * s2 + 5]); a.w = pk2(sv[8 * s2 + 6], sv[8 * s2 + 7]); pf[s2] = __builtin_bit_cast(bf16x8, a); }
#pragma unroll
            for (int dt = 0; dt < 4; ++dt)
#pragma unroll
                for (int s2 = 0; s2 < 2; ++s2) { const u32x4 v4 = *(const LAS u32x4*)(ldsV + (32 * dt + q) * VP + (2 * hf + s2) * 32 + 16 * h);
                    o[dt] = MFMA32(__builtin_bit_cast(bf16x8, v4), pf[s2], o[dt]); }
        }
        if (more) { const int nb = ((kt + 1) & 1) * BUF;
            *(LAS u32x4*)(F.lds + nb + kl) = pk0; *(LAS u32x4*)(F.lds + nb + kl + 32 * KP) = pk1; *(LAS u32x2*)(F.lds + nb + vl) = (u32x2){pv0.x, pv0.y}; *(LAS u32x2*)(F.lds + nb + vl + 16) = (u32x2){pv0.z, pv0.w}; *(LAS u32x2*)(F.lds + nb + vl + 64 * VP) = (u32x2){pv1.x, pv1.y}; *(LAS u32x2*)(F.lds + nb + vl + 64 * VP + 16) = (u32x2){pv1.z, pv1.w}; }
        __syncthreads();
    }
    float inv = 1.0f / xsum32(lrun);
    unsigned char* yp = F.ws + WS_Y8 + rowq * 2048 + hq * 128;
    inv *= F8_SY;
#pragma unroll
    for (int dt = 0; dt < 4; ++dt) { unsigned w4[4];
#pragma unroll
        for (int gq = 0; gq < 4; ++gq) w4[gq] = pk4_fp8(o[dt][4 * gq] * inv, o[dt][4 * gq + 1] * inv, o[dt][4 * gq + 2] * inv, o[dt][4 * gq + 3] * inv);
        const auto r02 = __builtin_amdgcn_permlane32_swap(w4[0], w4[2], false, false); const auto r13 = __builtin_amdgcn_permlane32_swap(w4[1], w4[3], false, false);
        *(u32x4*)(yp + 32 * dt + 16 * h) = (u32x4){r02[0], r02[1], r13[0], r13[1]}; }
}

__device__ __forceinline__ void xattn_unit(Frame& F, int unit) {
    constexpr int KP = 528, VP = 144;
    const int tile = unit & 15, hx = (unit >> 4) & 3, b = unit >> 6;
    int tz = F.tid; asm volatile("" : "+v"(tz));
    const int w = F.wave, lane = tz & 63, fr = lane & 15, fq = lane >> 4;
    const size_t rowq = (size_t)(b * SEQ + tile * 128 + 16 * w + fr);
    const bf16_t* kx = (const bf16_t*)(F.ws + WS_KX); const bf16_t* vxT = (const bf16_t*)(F.ws + WS_VXT);
    bf16x8 qf[8];
    { const bf16_t* q0 = (const bf16_t*)(F.ws + WS_QX0) + rowq * 1024 + hx * 256 + 8 * fq; const bf16_t* q1 = (const bf16_t*)(F.ws + WS_QX1) + rowq * 1024 + hx * 256 + 8 * fq;
#pragma unroll
      for (int ds = 0; ds < 8; ++ds) { float a[8], c[8]; unpack8(*(const u32x4*)(q0 + 32 * ds), a); unpack8(*(const u32x4*)(q1 + 32 * ds), c);
#pragma unroll
          for (int j = 0; j < 8; ++j) a[j] += c[j];
          qf[ds] = __builtin_bit_cast(bf16x8, pack8(a)); } }
    f32x4 ot[16];
#pragma unroll
    for (int i = 0; i < 16; ++i) ot[i] = (f32x4){0.f, 0.f, 0.f, 0.f};
    float mrun = -1.0e30f, l = 0.f;
    LAS unsigned char* ldsK = F.lds; LAS unsigned char* ldsV = F.lds + 64 * KP;
    const bf16_t* kgp = kx + (size_t)(b * 256 + (tz >> 5)) * 1024 + hx * 256 + (tz & 31) * 8;
    const bf16_t* vgp = vxT + (size_t)(hx * 256 + (tz >> 3)) * 1024 + b * 256 + (tz & 7) * 8;
    const int klo = (tz >> 5) * KP + (tz & 31) * 16, vlo = 64 * KP + (tz >> 3) * VP + (tz & 7) * 16;
    u32x4 kr[4], vr[4];
#pragma unroll
    for (int k = 0; k < 4; ++k) { kr[k] = *(const u32x4*)(kgp + (size_t)(16 * k) * 1024); vr[k] = *(const u32x4*)(vgp + (size_t)(64 * k) * 1024); }
#pragma unroll 1
    for (int ch = 0; ch < 4; ++ch) {
        __syncthreads();
#pragma unroll
        for (int k = 0; k < 4; ++k) { *(LAS u32x4*)(F.lds + klo + 16 * k * KP) = kr[k]; *(LAS u32x4*)(F.lds + vlo + 64 * k * VP) = vr[k]; }
        if (ch < 3) {
#pragma unroll
            for (int k = 0; k < 4; ++k) { kr[k] = *(const u32x4*)(kgp + (size_t)((ch + 1) * 64 + 16 * k) * 1024); vr[k] = *(const u32x4*)(vgp + (size_t)(64 * k) * 1024 + (ch + 1) * 64); } }
        __syncthreads();
        f32x4 st[4];
#pragma unroll
        for (int k4 = 0; k4 < 4; ++k4) { st[k4] = (f32x4){0.f, 0.f, 0.f, 0.f};
#pragma unroll
            for (int ds = 0; ds < 8; ++ds) { const bf16x8 kf = *(const LAS bf16x8*)(ldsK + (16 * k4 + fr) * KP + (32 * ds + 8 * fq) * 2); st[k4] = MFMA16(kf, qf[ds], st[k4]); } }
        float mx = -1.0e30f;
#pragma unroll
        for (int i = 0; i < 4; ++i) mx = fmaxf(mx, fmaxf(fmaxf(st[i][0], st[i][1]), fmaxf(st[i][2], st[i][3])));
        mx = fmaxf(mx, shx(mx, lane, 16)); mx = fmaxf(mx, shx(mx, lane, 32));
        const float mnew = fmaxf(mrun, mx), alpha = __builtin_amdgcn_exp2f((mrun - mnew) * 1.4426950408889634f), mc = mnew * 1.4426950408889634f; mrun = mnew;
        float ps = 0.f;
#pragma unroll
        for (int i = 0; i < 4; ++i)
#pragma unroll
            for (int e = 0; e < 4; ++e) { st[i][e] = __builtin_amdgcn_exp2f(st[i][e] * 1.4426950408889634f - mc); ps += st[i][e]; }
        l = l * alpha + ps;
#pragma unroll
        for (int i = 0; i < 16; ++i) ot[i] *= alpha;
        bf16x8 pf[2];
#pragma unroll
        for (int k2 = 0; k2 < 2; ++k2) { u32x4 a; a.x = pk2(st[2 * k2][0], st[2 * k2][1]); a.y = pk2(st[2 * k2][2], st[2 * k2][3]); a.z = pk2(st[2 * k2 + 1][0], st[2 * k2 + 1][1]); a.w = pk2(st[2 * k2 + 1][2], st[2 * k2 + 1][3]); pf[k2] = __builtin_bit_cast(bf16x8, a); }
#pragma unroll
        for (int k2 = 0; k2 < 2; ++k2)
#pragma unroll
            for (int dt = 0; dt < 16; ++dt) { const LAS unsigned char* vp = ldsV + (16 * dt + fr) * VP + (32 * k2 + 4 * fq) * 2;
                const u32x2 a = *(const LAS u32x2*)vp, c = *(const LAS u32x2*)(vp + 32); u32x4 v4; v4.x = a.x; v4.y = a.y; v4.z = c.x; v4.w = c.y;
                ot[dt] = MFMA16(__builtin_bit_cast(bf16x8, v4), pf[k2], ot[dt]); }
    }
    l += shx(l, lane, 16); l += shx(l, lane, 32);
    const float inv = 1.0f / l;
    bf16_t* op = (bf16_t*)(F.ws + WS_OX) + rowq * 1024 + hx * 256 + 4 * fq;
#pragma unroll
    for (int dt = 0; dt < 16; ++dt) { u32x2 ow; ow.x = pk2(ot[dt][0] * inv, ot[dt][1] * inv); ow.y = pk2(ot[dt][2] * inv, ot[dt][3] * inv); *(u32x2*)(op + 16 * dt) = ow; }
}

__global__ void __launch_bounds__(512, 2) hybrid_fwd(Params P) {
    extern __shared__ __attribute__((aligned(16))) unsigned char lds_raw[];
    Frame F;
    F.lds = (LAS unsigned char*)lds_raw; F.tid = threadIdx.x; F.lane = F.tid & 63; F.wave = __builtin_amdgcn_readfirstlane(F.tid >> 6); F.G = gridDim.x; F.bid = blockIdx.x;
    F.ws = P.ws;
    volatile LAS unsigned* MISC = (volatile LAS unsigned*)(F.lds + LDSCTL_OFF);
    for (int u = F.tid; u < (LDS_BYTES - LDSCTL_OFF) / 4; u += 512) MISC[u] = 0u;
    __syncthreads();
    XcdBarrier bar; bar.bar = (unsigned*)(P.ws + WS_CTL) + CW_BAR; bar.x = 0; bar.st = nullptr;
    if (MK_N_LAUNCHES == 1) bar = xcd_barrier_post((unsigned*)(P.ws + WS_CTL) + CW_BAR, MISC + 8);
    const int lo = P.ph_lo, hi = P.ph_hi;
#define IN(k) ((((PH_MASK) >> (k)) & 1) && lo <= (k) && (k) < hi)
#define SEAM(k) do { if (IN(k) && IN((k) + 1)) xcd_barrier(bar); } while (0)
    const int G = F.G, c = F.bid;
    unsigned char* ws = P.ws;

    const int NFREE = (G >= 240) ? N_FREE_WG : 0, Gg = G - NFREE;
    if (IN(0)) { p0_prologue(F, P, NFREE == 0); if (DUP_PHASE == 0) { xcd_barrier(bar); p0_prologue(F, P, NFREE == 0); } } SEAM(0);

    if (IN(1)) {
        EpiProj<0> E0{F_PROJ, F_VT, (bf16_t*)(ws + WS_VTA), F_RSTDX, F_SSQV, F_ROPEB, F_ROPEI, (bf16_t*)(ws + WS_KX), (bf16_t*)(ws + WS_VXT), F_RSTDM, 1.0f};
        EpiProj<1> E8{F_PROJ, F_VT, (bf16_t*)(ws + WS_VTA), F_RSTDX, F_SSQV, F_ROPEB, F_ROPEI, (bf16_t*)(ws + WS_KX), (bf16_t*)(ws + WS_VXT), F_RSTDM, F8_INV};
        EpiProj<2> EK{F_PROJ, F_VT, (bf16_t*)(ws + WS_VTA), F_RSTDX, F_SSQV, F_ROPEB, F_ROPEI, (bf16_t*)(ws + WS_KX), (bf16_t*)(ws + WS_VXT), F_RSTDM, 1.0f};
        SchedKV SK{NFREE ? NFREE : G, NFREE ? c - Gg : c, (const char*)(ws + WS_MEMB), (const char*)(ws + WS_WK), (const char*)(ws + WS_WV)};
        if (c >= Gg) {
            pg8::gemm_phase<false>(F.lds, DM, DM, DM, SK, EK);
            convert_late(F, P, (unsigned*)(ws + CT_CVT));
        } else {
            const int rot = (1408 % Gg) & ~7;
            SchedZa SZ{Gg, c, (const char*)(ws + WS_XB), (const char*)(ws + WS_WIN)};
            pg8::gemm_phase<false>(F.lds, DM, DM, DM, SZ, E0);
            const int nb4 = 672 % Gg, e8 = 1408 % Gg; const bool bal = (Gg == 216);
            const int skip5 = bal && c < nb4, extra = (bal && c >= nb4 && c < 2 * nb4) ? (c - nb4 + rot) % Gg : -1;
            SchedF8 S8{Gg, (c + rot) % Gg, skip5, extra, (const char*)(ws + WS_XB8), (const char*)(ws + WS_WIN8)};
            pg8::gemm_phase<true>(F.lds, DM, DM, DM, S8, E8);
            if (!NFREE) pg8::gemm_phase<false>(F.lds, DM, DM, DM, SK, EK);
        }
    } SEAM(1);

    if (IN(2)) {
        for (int u = c; u < 256; u += G) { const int b = u >> 6, j = u & 63; indexer_unit(F, b, j); indexer_unit(F, b, 127 - j); }
        for (int u = c; u < 1024; u += G) spatial_unit(F, P, u);
        if (DUP_PHASE == 2) { xcd_barrier(bar);
            for (int u = c; u < 256; u += G) { const int b = u >> 6, j = u & 63; indexer_unit(F, b, j); indexer_unit(F, b, 127 - j); }
            for (int u = c; u < 1024; u += G) spatial_unit(F, P, u); }
    } SEAM(2);

    if (IN(3)) {
        for (int u = c; u < 256; u += G) { const int j = u & 15, kvh = (u >> 4) & 3, b = u >> 6; attn_unit(F, b, kvh, 31 - j); attn_unit(F, b, kvh, j); }
        if (DUP_PHASE == 3) { xcd_barrier(bar); for (int u = c; u < 256; u += G) { const int j = u & 15, kvh = (u >> 4) & 3, b = u >> 6; attn_unit(F, b, kvh, 31 - j); attn_unit(F, b, kvh, j); } }
    } SEAM(3);

    if (IN(4)) {
        EpiMerge E{F_MRG, F_PROJ};
        f32x4 acc4[2][2][4][2];
#define P4_TILE(L) do { if ((L) < 512) { Unit u; pg8::tile_of((L), 32, 16, u.pm, u.pn); \
            u.kind = 0; u.A = (const char*)F_Y + (size_t)u.pm * 256 * DM * 2; u.B = (const char*)(ws + WS_PA) + (size_t)u.pn * 256 * 2048 * 2; \
            { SchedOne S{u}; pg8::gemm_phase_acc<false>(F.lds, 2048, DM, 2048, S, E, acc4, true); }       \
            u.kind = 1; u.A = (const char*)(ws + WS_Y8) + (size_t)u.pm * 256 * 2048; u.B = (const char*)(ws + WS_PB) + (size_t)u.pn * 256 * 2048; \
            { SchedOne S{u}; pg8::gemm_phase_acc<true>(F.lds, 2048, 2048, 2048, S, E, acc4, false); } } } while (0)
        P4_TILE(c); P4_TILE(c + G);
        if (c + 2 * G < 512) __builtin_trap();
#undef P4_TILE
    } SEAM(4);

    if (IN(5)) {
        SchedSimple S{G, c, 32, 16, (const char*)F_MRG, (const char*)(ws + WS_WOUT), (size_t)256 * DM * 2, (size_t)256 * DM * 2};
        EpiResid<true> E{P.x, (bf16_t*)(ws + WS_X1B), F_SSQ1};
        pg8::gemm_phase<false>(F.lds, DM, DM, DM, S, E);
    } SEAM(5);

    if (IN(6)) {
        SchedG6 S{G, c, (const char*)(ws + WS_X1B), (const char*)(ws + WS_WQ)};
        EpiQx E{(bf16_t*)(ws + WS_QX0), (bf16_t*)(ws + WS_QX1), F_SSQ1};
        pg8::gemm_phase<false>(F.lds, 2048, DM, DM, S, E);
        if (DUP_PHASE == 6) { xcd_barrier(bar); pg8::gemm_phase<false>(F.lds, 2048, DM, DM, S, E); }
    } SEAM(6);

    if (IN(7)) { for (int u = c; u < 256; u += G) xattn_unit(F, u); if (DUP_PHASE == 7) { xcd_barrier(bar); for (int u = c; u < 256; u += G) xattn_unit(F, u); } } SEAM(7);

    if (IN(8)) {
        SchedSimple S{G, c, 32, 16, (const char*)(ws + WS_OX), (const char*)(ws + WS_WO), (size_t)256 * 1024 * 2, (size_t)256 * 1024 * 2};
        EpiResid<false> E{(const void*)(ws + WS_X1B), (bf16_t*)(ws + WS_X2B), F_SSQ2};
        pg8::gemm_phase<false>(F.lds, 1024, 1024, 1024, S, E);
    } SEAM(8);

    if (IN(9)) {
        SchedSimple S{G, c, 32, 86, (const char*)(ws + WS_X2B), (const char*)(ws + WS_W13), (size_t)256 * DM * 2, (size_t)256 * DM * 2};
        EpiFfnUp E{(bf16_t*)(ws + WS_HDN), F_SSQ2};
        pg8::gemm_phase<false>(F.lds, DM, DM, DM, S, E);
        if (DUP_PHASE == 9) { xcd_barrier(bar); pg8::gemm_phase<false>(F.lds, DM, DM, DM, S, E); }
    } SEAM(9);

    if (IN(10)) {
        SchedSimple S{G, c, 32, 16, (const char*)(ws + WS_HDN), (const char*)(ws + WS_W2), (size_t)256 * FFN * 2, (size_t)256 * FFN * 2};
        EpiResid<false> E{(const void*)(ws + WS_X2B), (bf16_t*)(ws + WS_X3B), F_SSQ3};
        pg8::gemm_phase<false>(F.lds, FFN, FFN, FFN, S, E);
    } SEAM(10);

    if (IN(11)) {
        const int gw = c * 8 + F.wave, NGW = G * 8, lane = F.lane; const bf16_t* x3 = (const bf16_t*)(ws + WS_X3B);
        for (int m = gw; m < M; m += NGW) { const float rs = __builtin_amdgcn_rsqf(F_SSQ3[m] * (1.f / DM) + EPS);
#pragma unroll
            for (int j = 0; j < 8; ++j) { const int col = 512 * j + 8 * lane; float v[8]; unpack8(*(const u32x4*)(x3 + (size_t)m * DM + col), v);
                const f32x4 g0 = *(const f32x4*)(P.final_g + col), g1 = *(const f32x4*)(P.final_g + col + 4);
                f32x4 o0, o1; o0[0] = v[0] * rs * g0[0]; o0[1] = v[1] * rs * g0[1]; o0[2] = v[2] * rs * g0[2]; o0[3] = v[3] * rs * g0[3]; o1[0] = v[4] * rs * g1[0]; o1[1] = v[5] * rs * g1[1]; o1[2] = v[6] * rs * g1[2]; o1[3] = v[7] * rs * g1[3];
                *(f32x4*)(P.out + (size_t)m * DM + col) = o0; *(f32x4*)(P.out + (size_t)m * DM + col + 4) = o1; } }
    }
#undef IN
#undef SEAM
}

extern "C" void kernel_launch(void* const* d_in, const int* in_sizes, int n_in, void* d_out, int out_size, void* d_ws, size_t ws_size, hipStream_t stream) {
    static int grid = 0;
    if (grid == 0) {
        if (n_in != 22 || out_size != M * DM || ws_size < WS_END) { fprintf(stderr, "kernel_launch: unexpected problem (n_in %d, out %d, ws %zu)\n", n_in, out_size, ws_size); grid = -1; return; }
        int dev = 0, cus = 0, per_cu = 0;
        if (hipGetDevice(&dev) != hipSuccess || hipDeviceGetAttribute(&cus, hipDeviceAttributeMultiprocessorCount, dev) != hipSuccess) { grid = -1; return; }
        if (hipFuncSetAttribute((const void*)hybrid_fwd, hipFuncAttributeMaxDynamicSharedMemorySize, LDS_BYTES) != hipSuccess) { fprintf(stderr, "kernel_launch: hipFuncSetAttribute failed\n"); grid = -1; return; }
        if (hipOccupancyMaxActiveBlocksPerMultiprocessor(&per_cu, (const void*)hybrid_fwd, 512, LDS_BYTES) != hipSuccess || per_cu < 1) fprintf(stderr, "kernel_launch: occupancy query reports %d\n", per_cu);
        (void)hipGetLastError();
        grid = cus;
    }
    if (grid < 0) return;
    if (hipMemsetAsync((char*)d_ws + WS_CTL, 0, CTL_ZERO_BYTES, stream) != hipSuccess) return;
    Params p{};
    p.x = (const float*)d_in[0]; p.mem = (const float*)d_in[1]; p.pos = (const int*)d_in[2];
    p.norm_mix_g = (const float*)d_in[3]; p.w_in = (const float*)d_in[4]; p.a_norm_g = (const float*)d_in[5]; p.a_sw = (const float*)d_in[6]; p.a_sb = (const float*)d_in[7];
    p.p_a = (const float*)d_in[8]; p.p_b = (const float*)d_in[9]; p.w_out = (const float*)d_in[10]; p.norm_x_g = (const float*)d_in[11]; p.norm_mem_g = (const float*)d_in[12];
    p.xq = (const float*)d_in[13]; p.xk = (const float*)d_in[14]; p.xv = (const float*)d_in[15]; p.xo = (const float*)d_in[16]; p.norm_ffn_g = (const float*)d_in[17];
    p.w1 = (const float*)d_in[18]; p.w3 = (const float*)d_in[19]; p.w2 = (const float*)d_in[20]; p.final_g = (const float*)d_in[21];
    p.out = (float*)d_out; p.ws = (unsigned char*)d_ws;
    for (int li = 0; li < MK_N_LAUNCHES; ++li) {
        p.ph_lo = (MK_N_LAUNCHES == 1) ? 0 : li; p.ph_hi = (MK_N_LAUNCHES == 1) ? NPHASE : li + 1;
        hipLaunchKernelGGL(hybrid_fwd, dim3(grid), dim3(512), LDS_BYTES, stream, p);
    }
}
```

```cpp
#include <hip/hip_runtime.h>
#include <cstdio>
#include <cstdint>

#ifndef MK_N_LAUNCHES
#define MK_N_LAUNCHES 1
#endif

#ifndef DUP_PHASE
#define DUP_PHASE -1
#endif
#ifndef PH_MASK
#define PH_MASK 0xFFF
#endif
#define LAS __attribute__((address_space(3)))
#define GAS __attribute__((address_space(1)))
typedef unsigned short bf16_t;
typedef short bf16x8 __attribute__((ext_vector_type(8)));
typedef float f32x4 __attribute__((ext_vector_type(4)));
typedef float f32x16 __attribute__((ext_vector_type(16)));
typedef unsigned u32x4 __attribute__((ext_vector_type(4)));
typedef unsigned u32x2 __attribute__((ext_vector_type(2)));
typedef int v8i __attribute__((ext_vector_type(8)));
typedef __bf16 bf16x2_t __attribute__((ext_vector_type(2)));
typedef float f32x2_t __attribute__((ext_vector_type(2)));

constexpr int NB = 4, SEQ = 2048, M = NB * SEQ, DM = 4096, MEMR = 1024;
constexpr int NPROJ = 16640;
constexpr int C_U = 0, C_V = 2048, C_Q = 4096, C_K = 6144, C_VV = 6656, C_QI = 7168, C_KI = 8192, C_WI = 8256, C_GA = 8448, C_GB = 12544;
constexpr int FFN = 11008, N13 = 22016;
constexpr float EPS = 1e-6f;
constexpr int NPHASE = 12;

constexpr size_t MiB = 1u << 20;
constexpr size_t WS_CTL = 0, CTL_ZERO_BYTES = 1 * MiB;
constexpr int CW_BAR = 4096;
constexpr size_t CT_CVT = 32768;
constexpr size_t CT_SSQV = 65536, CT_SSQ1 = 98304, CT_SSQ2 = 131072, CT_SSQ3 = 163840;
constexpr size_t WS_RSTDX = 1 * MiB, WS_RSTDM = 1 * MiB + 65536, WS_ROPEB = 2 * MiB, WS_ROPEI = 3 * MiB, WS_WC = 3 * MiB + 524288, WS_MASK = 4 * MiB;
constexpr size_t WS_VT = 6 * MiB, WS_MEMB = 14 * MiB, WS_WIN = 22 * MiB, WS_PA = 152 * MiB, WS_PB = 168 * MiB, WS_WOUT = 184 * MiB;
constexpr size_t WS_WQ = 216 * MiB, WS_WK = 224 * MiB, WS_WV = 232 * MiB, WS_WO = 240 * MiB, WS_W13 = 248 * MiB, WS_W2 = 420 * MiB;
constexpr size_t WS_XB = 506 * MiB, WS_PROJ = 570 * MiB, WS_Y = 830 * MiB, WS_MRG = 894 * MiB, WS_KX = 958 * MiB, WS_VXT = 960 * MiB, WS_VTA = 962 * MiB, WS_Y8 = 994 * MiB, WS_END = 1010 * MiB;
constexpr size_t WS_WIN8 = 64 * MiB, WS_XB8 = WS_Y;
constexpr float F8_SA = 16.f, F8_SB = 1024.f, F8_INV = 1.f / (16.f * 1024.f), F8_SY = 64.f, F8_SPB = 512.f, F8_SYP = 64.f * 512.f, F8_IYP = 1.f / (64.f * 512.f);
constexpr size_t WS_HDN = WS_PROJ, WS_X1B = WS_Y, WS_X3B = WS_Y, WS_X2B = WS_XB, WS_QX0 = WS_MRG, WS_QX1 = WS_MRG + 16 * MiB, WS_OX = WS_MRG + 32 * MiB;
static_assert(WS_WIN + (size_t)NPROJ * DM * 2 <= WS_PA && WS_W13 + (size_t)N13 * DM * 2 <= WS_W2 && WS_W2 + (size_t)DM * FFN * 2 <= WS_XB, "weights map");
static_assert(WS_PROJ + (size_t)M * NPROJ * 2 <= WS_Y && WS_HDN + (size_t)M * FFN * 2 <= WS_Y, "proj map");

constexpr int RING_BYTES = 139264;
constexpr int LDSCTL_OFF = RING_BYTES, LDS_BYTES = RING_BYTES + 512;

__device__ __forceinline__ unsigned pk2(float lo, float hi) { f32x2_t v = {lo, hi}; bf16x2_t b = __builtin_convertvector(v, bf16x2_t); return __builtin_bit_cast(unsigned, b); }
__device__ __forceinline__ float bf_lo(unsigned w) { return __uint_as_float(w << 16); }
__device__ __forceinline__ float bf_hi(unsigned w) { return __uint_as_float(w & 0xffff0000u); }
__device__ __forceinline__ float bf1(bf16_t b) { return __uint_as_float(((unsigned)b) << 16); }
__device__ __forceinline__ void unpack8(const u32x4 r, float (&f)[8]) { f[0] = bf_lo(r.x); f[1] = bf_hi(r.x); f[2] = bf_lo(r.y); f[3] = bf_hi(r.y); f[4] = bf_lo(r.z); f[5] = bf_hi(r.z); f[6] = bf_lo(r.w); f[7] = bf_hi(r.w); }
__device__ __forceinline__ u32x4 pack8(const float (&f)[8]) { u32x4 w; w.x = pk2(f[0], f[1]); w.y = pk2(f[2], f[3]); w.z = pk2(f[4], f[5]); w.w = pk2(f[6], f[7]); return w; }
__device__ __forceinline__ unsigned pk4_fp8(float a, float b, float c, float d) { int w = 0; w = __builtin_amdgcn_cvt_pk_fp8_f32(a, b, w, false); w = __builtin_amdgcn_cvt_pk_fp8_f32(c, d, w, true); return (unsigned)w; }
__device__ __forceinline__ float sigmoidf_(float x) { return __builtin_amdgcn_rcpf(1.f + __builtin_amdgcn_exp2f(-1.44269504f * x)); }
__device__ __forceinline__ float gelu_tanh(float x) { const float z = 1.5957691216f * x * (1.f + 0.044715f * x * x); return x * sigmoidf_(z); }
__device__ __forceinline__ float wave_sum(float v) {
#pragma unroll
    for (int o = 1; o < 64; o <<= 1) v += __shfl_xor(v, o);
    return v;
}
__device__ __forceinline__ float shx(float v, int lane, int m) { return __int_as_float(__builtin_amdgcn_ds_bpermute(((lane ^ m) & 63) << 2, __float_as_int(v))); }
__device__ __forceinline__ float xmax32(float t) { const auto r = __builtin_amdgcn_permlane32_swap(__float_as_uint(t), __float_as_uint(t), false, false); return fmaxf(__uint_as_float(r[0]), __uint_as_float(r[1])); }
__device__ __forceinline__ float xsum32(float t) { const auto r = __builtin_amdgcn_permlane32_swap(__float_as_uint(t), __float_as_uint(t), false, false); return __uint_as_float(r[0]) + __uint_as_float(r[1]); }
#define LDS_WAIT() asm volatile("s_waitcnt lgkmcnt(0)" ::: "memory")
#define MFMA32(a, b, c) __builtin_amdgcn_mfma_f32_32x32x16_bf16((a), (b), (c), 0, 0, 0)
#define MFMA16(a, b, c) __builtin_amdgcn_mfma_f32_16x16x32_bf16((a), (b), (c), 0, 0, 0)

#define XB_TMO      128
#define XB_XCNT(j)  (256  + 64 * (j))
#define XB_XSUB(j)  (1280 + 64 * (j))
#define XB_XGEN(j)  (2304 + 64 * (j))
#define XB_TOP      3328
#define XB_TOPGEN   3392
#define XCD_BAR_WORDS 3456
#define XB_SPIN_CAP (1u << 18)
__device__ __forceinline__ unsigned xb_ld(unsigned* p)              { return __hip_atomic_load(p, __ATOMIC_RELAXED, __HIP_MEMORY_SCOPE_AGENT); }
__device__ __forceinline__ unsigned xb_add(unsigned* p, unsigned v) { return __hip_atomic_fetch_add(p, v, __ATOMIC_RELAXED, __HIP_MEMORY_SCOPE_AGENT); }
__device__ __forceinline__ unsigned xb_xcc_id() { return (unsigned)__builtin_amdgcn_s_getreg((3 << 11) | 20) & 0xFu; }
#define XB_SPIN(cond, bar) do { unsigned _sp = 0; while (cond) { __builtin_amdgcn_s_sleep(1); \
    if ((++_sp & 255u) == 0u) { if (xb_ld(&(bar)[XB_TMO])) break; if (_sp > XB_SPIN_CAP) { atomicAdd(&(bar)[XB_TMO], 1u); break; } } } } while (0)
struct XcdBarrier { unsigned* bar; unsigned x; volatile LAS unsigned* st; };
__device__ __forceinline__ XcdBarrier xcd_barrier_post(unsigned* bar, volatile LAS unsigned* st) {
    XcdBarrier b; b.bar = bar; b.x = xb_xcc_id(); b.st = st;
    if (threadIdx.x == 0) (void)xb_add(&bar[XB_XCNT(b.x)], 1u);
    return b;
}
__device__ __forceinline__ void xcd_barrier_complete(unsigned* bar, unsigned x, unsigned& nloc, unsigned& nx) {
    const unsigned G = gridDim.x * gridDim.y * gridDim.z;
    unsigned sum, cnt, mine, sp = 0u;
    for (;;) {
        sum = 0u; cnt = 0u; mine = 0u;
#pragma unroll
        for (unsigned j = 0; j < 16; ++j) { const unsigned c = xb_ld(&bar[XB_XCNT(j)]); sum += c; cnt += (c > 0u) ? 1u : 0u; mine = (j == x) ? c : mine; }
        if (sum == G) break;
        __builtin_amdgcn_s_sleep(1);
        if ((++sp & 255u) == 0u) { if (xb_ld(&bar[XB_TMO])) break; if (sp > XB_SPIN_CAP) { atomicAdd(&bar[XB_TMO], 1u); break; } }
    }
    nloc = mine > 0u ? mine : 1u; nx = cnt > 0u ? cnt : 1u;
}
__device__ __forceinline__ void xcd_barrier(const XcdBarrier& b) {
    asm volatile("s_waitcnt vmcnt(0)" ::: "memory");
    __syncthreads();
    if (threadIdx.x == 0) {
        unsigned* bar = b.bar;
        __builtin_amdgcn_s_waitcnt(0);
        unsigned nloc = b.st[0], nx = b.st[1];
        if (nloc == 0u) { xcd_barrier_complete(bar, b.x, nloc, nx); b.st[0] = nloc; b.st[1] = nx; }
        const unsigned old = xb_add(&bar[XB_XSUB(b.x)], 1u);
        const unsigned gen = old / nloc;
        if (old + 1u == (gen + 1u) * nloc) {
            __builtin_amdgcn_fence(__ATOMIC_RELEASE, "agent");
            asm volatile("s_waitcnt vmcnt(0)" ::: "memory");
            const unsigned og = xb_add(&bar[XB_TOP], 1u);
            const unsigned tg = og / nx;
            if (og + 1u == (tg + 1u) * nx) xb_add(&bar[XB_TOPGEN], 1u);
            else XB_SPIN(xb_ld(&bar[XB_TOPGEN]) == tg, bar);
            __builtin_amdgcn_fence(__ATOMIC_ACQUIRE, "agent");
            xb_add(&bar[XB_XGEN(b.x)], 1u);
            asm volatile("s_waitcnt vmcnt(0)" ::: "memory");
        } else {
            XB_SPIN(xb_ld(&bar[XB_XGEN(b.x)]) == gen, bar);
            __builtin_amdgcn_fence(__ATOMIC_ACQUIRE, "agent");
            asm volatile("s_waitcnt vmcnt(0)" ::: "memory");
        }
    }
    __syncthreads();
}

namespace pg8 {
constexpr int BM = 256, BK = 64, HALF = 128, HTB = HALF * BK * 2, STAGE_BYTES = 8 * HTB;
__device__ __forceinline__ int lds_byte(int r, int c) { const int st = (r >> 4) * 2 + (c >> 5), rr = r & 15, cc = c & 31, ob = rr * 64 + cc * 2; return st * 1024 + (ob ^ (((ob >> 9) & 1) << 5)); }
__device__ __forceinline__ void stage_rc(int b, int& R, int& C) { const int st = b / 1024, sb = b % 1024, swz = sb ^ (((sb >> 9) & 1) << 5); R = (st >> 1) * 16 + swz / 64; C = (st & 1) * 32 + (swz % 64) / 2; }
__device__ __forceinline__ int perm32(int rho) { const int n = rho >> 4, i = rho & 15; return 8 * (i >> 2) + 4 * n + (i & 3); }
struct Unit { const char* A; const char* B; int pm, pn, kind; };
__device__ __forceinline__ void tile_of(int L, int nM, int nN, int& pm, int& pn) {
    const int nwg = nM * nN; int wgid = L;
    { const int q = nwg / 8, r = nwg % 8, xcd = wgid % 8, off = wgid / 8; wgid = (xcd < r ? xcd * (q + 1) : r * (q + 1) + (xcd - r) * q) + off; }
    const int nig = 8 * nN, gid = wgid / nig, fm = gid * 8, gsz = (nM - fm) < 8 ? (nM - fm) : 8;
    pm = fm + ((wgid % nig) % gsz); pn = (wgid % nig) / gsz;
}
template <bool F8, class Epi, class Sched>
__device__ __forceinline__ void gemm_phase_acc(LAS unsigned char* lds, const int K, const int lda, const int ldb, const Sched& S, const Epi& E, f32x4 (&acc)[2][2][4][2], const bool zero_first) {
    int tid = threadIdx.x; asm volatile("" : "+v"(tid));
    const int wid = __builtin_amdgcn_readfirstlane(tid >> 6), lane = tid & 63, wr = wid >> 2, wc = wid & 3, fr = lane & 15, fq = lane >> 4;
    constexpr int EB = F8 ? 1 : 2;
    const int nt = K * EB / (BK * 2);
    unsigned voffA[2], voffB[2];
#pragma unroll
    for (int i = 0; i < 2; ++i) { int R, C; stage_rc(tid * 16 + i * 8192, R, C); const int Rb = (R & ~31) + perm32(R & 31);
        voffA[i] = (unsigned)(R * lda * EB + C * 2); voffB[i] = (unsigned)(Rb * ldb * EB + C * 2); }
    const size_t kstep = (size_t)(BK * 2);
    const size_t hstepA = (size_t)HALF * lda * EB, hstepB = (size_t)HALF * ldb * EB;
    const unsigned ldsw = (unsigned)wid * 1024u;
    const unsigned ldsbase = (unsigned)(unsigned long)lds;
    const int aoff = F8 ? lds_byte(wr * 64 + fr, fq * 16) : lds_byte(wr * 64 + fr, fq * 8), boff = F8 ? lds_byte(wc * 32 + fr, fq * 16) : lds_byte(wc * 32 + fr, fq * 8);
    constexpr int KOFF = F8 ? 16 : 1024;
    const int sw8 = F8 ? 16 * (fq & 1) : 0, aoffx = aoff + sw8, boffx = boff + sw8, aoffy = aoff + KOFF - sw8, boffy = boff + KOFF - sw8;
#define PG8_SA(b, h) (((b) * 2 + (h)) * HTB)
#define PG8_SB(b, h) ((4 + (b) * 2 + (h)) * HTB)
#define PG8_STAGE(bufoff, gbase, voff) do { _Pragma("unroll") for (int _i = 0; _i < 2; ++_i) \
        __builtin_amdgcn_global_load_lds((const unsigned*)((const char*)(gbase) + (voff)[_i]), (LAS unsigned*)(lds + (bufoff) + ldsw + _i * 8192), 16, 0, 0); } while (0)
#define PG8_STAGE8(bufoff, gbase, voff) do { _Pragma("unroll") for (int _i = 0; _i < 2; ++_i) { unsigned _keep; \
        asm volatile("s_mov_b32 %0, m0\n\ts_mov_b32 m0, %3\n\ts_nop 0\n\tglobal_load_lds_dwordx4 %1, %2\n\ts_mov_b32 m0, %0" : "=&s"(_keep) : "v"((voff)[_i]), "s"((const char*)(gbase)), "s"(ldsbase + (unsigned)(bufoff) + ldsw + _i * 8192u)); } } while (0)
#define PG8_LDA(dst, b, h) do { _Pragma("unroll") for (int m = 0; m < 4; ++m) _Pragma("unroll") for (int k = 0; k < 2; ++k) dst[m][k] = *(const LAS bf16x8*)(lds + PG8_SA(b, h) + aoff + m * 2048 + k * KOFF); } while (0)
#define PG8_LDB(dst, b, h) do { _Pragma("unroll") for (int n = 0; n < 2; ++n) _Pragma("unroll") for (int k = 0; k < 2; ++k) dst[n][k] = *(const LAS bf16x8*)(lds + PG8_SB(b, h) + boff + n * 2048 + k * KOFF); } while (0)
#define PG8_MMA(ai, bj, At, Bt) do { __builtin_amdgcn_s_setprio(1); _Pragma("unroll") for (int m = 0; m < 4; ++m) _Pragma("unroll") for (int n = 0; n < 2; ++n) { \
        if constexpr (F8) { const u32x4 _b0 = __builtin_bit_cast(u32x4, Bt[n][0]), _b1 = __builtin_bit_cast(u32x4, Bt[n][1]), _a0 = __builtin_bit_cast(u32x4, At[m][0]), _a1 = __builtin_bit_cast(u32x4, At[m][1]); \
            const v8i _bb = {(int)_b0.x, (int)_b0.y, (int)_b0.z, (int)_b0.w, (int)_b1.x, (int)_b1.y, (int)_b1.z, (int)_b1.w}, _aa = {(int)_a0.x, (int)_a0.y, (int)_a0.z, (int)_a0.w, (int)_a1.x, (int)_a1.y, (int)_a1.z, (int)_a1.w}; \
            acc[ai][bj][m][n] = __builtin_amdgcn_mfma_scale_f32_16x16x128_f8f6f4(_bb, _aa, acc[ai][bj][m][n], 0, 0, 0, 0, 0, 0); } \
        else { _Pragma("unroll") for (int k = 0; k < 2; ++k) acc[ai][bj][m][n] = __builtin_amdgcn_mfma_f32_16x16x32_bf16(Bt[n][k], At[m][k], acc[ai][bj][m][n], 0, 0, 0); } } \
        __builtin_amdgcn_s_setprio(0); } while (0)
#define PG8_WAIT_V(n) asm volatile("s_waitcnt vmcnt(" #n ")" ::: "memory")
#define PG8_WAIT_L(n) asm volatile("s_waitcnt lgkmcnt(" #n ")" ::: "memory")
#define PG8_BAR __builtin_amdgcn_s_barrier()
#define PG8_SCHED __builtin_amdgcn_sched_barrier(0)
    Unit cur, nxt; int ui = 0;
    if (!S.next(0, cur)) return;
    if (zero_first) {
#pragma unroll
    for (int a = 0; a < 2; ++a)
#pragma unroll
        for (int b = 0; b < 2; ++b)
#pragma unroll
            for (int m = 0; m < 4; ++m)
#pragma unroll
                for (int n = 0; n < 2; ++n) acc[a][b][m][n] = (f32x4){0.f, 0.f, 0.f, 0.f};
    }
    bf16x8 At[4][2], B0[2][2], B1[2][2];
    const char* cA = cur.A; const char* cB = cur.B;
    if constexpr (F8) {
    PG8_STAGE8(PG8_SB(0, 0), cB, voffB); PG8_STAGE8(PG8_SB(0, 1), cB + hstepB, voffB); PG8_STAGE8(PG8_SA(0, 0), cA, voffA); PG8_STAGE8(PG8_SA(0, 1), cA + hstepA, voffA);
    if (wr == 1) PG8_BAR;
    PG8_WAIT_V(2); PG8_BAR;
    PG8_STAGE8(PG8_SB(1, 0), cB + kstep, voffB); PG8_STAGE8(PG8_SA(1, 0), cA + kstep, voffA); PG8_STAGE8(PG8_SB(1, 1), cB + hstepB + kstep, voffB);
    PG8_WAIT_V(6); PG8_BAR;
    } else {
    PG8_STAGE(PG8_SB(0, 0), cB, voffB); PG8_STAGE(PG8_SB(0, 1), cB + hstepB, voffB); PG8_STAGE(PG8_SA(0, 0), cA, voffA); PG8_STAGE(PG8_SA(0, 1), cA + hstepA, voffA);
    if (wr == 1) PG8_BAR;
    PG8_WAIT_V(2); PG8_BAR;
    PG8_STAGE(PG8_SB(1, 0), cB + kstep, voffB); PG8_STAGE(PG8_SA(1, 0), cA + kstep, voffA); PG8_STAGE(PG8_SB(1, 1), cB + hstepB + kstep, voffB);
    PG8_WAIT_V(6); PG8_BAR;
    }
    for (;;) {
        const bool has_next = S.next(ui + 1, nxt);
        const char* nA = has_next ? nxt.A : cA; const char* nB = has_next ? nxt.B : cB;
        if constexpr (F8) {
        __builtin_amdgcn_s_waitcnt(0x0F70);
#pragma clang loop unroll(disable)
        for (int t = 0; t < nt; ++t) {
            const unsigned bo = (unsigned)(t & 1) * 32768u, bo1 = bo ^ 32768u;
            const char* a1 = (t + 1 < nt) ? cA + (size_t)(t + 1) * kstep : nA + (size_t)(t + 1 - nt) * kstep;
            const char* a2 = (t + 2 < nt) ? cA + (size_t)(t + 2) * kstep : nA + (size_t)(t + 2 - nt) * kstep;
            const char* b2 = (t + 2 < nt) ? cB + (size_t)(t + 2) * kstep : nB + (size_t)(t + 2 - nt) * kstep;
#define PG8_RLD(dst, NR, off, base) do { _Pragma("unroll") for (int q = 0; q < NR; ++q) _Pragma("unroll") for (int k = 0; k < 2; ++k) dst[q][k] = *(const LAS bf16x8*)(lds + (k ? base##y : base##x) + (off) + q * 2048); } while (0)
            PG8_RLD(B0, 2, bo + 4 * HTB, boff); PG8_RLD(B1, 2, bo + 5 * HTB, boff); PG8_SCHED; PG8_RLD(At, 4, bo, aoff); PG8_STAGE8(bo1 + HTB, a1 + hstepA, voffA);
            PG8_WAIT_V(8); PG8_WAIT_L(0); PG8_BAR; PG8_MMA(0, 0, At, B0); PG8_MMA(0, 1, At, B1); PG8_BAR; PG8_SCHED;
            PG8_RLD(At, 4, bo + HTB, aoff); PG8_STAGE8(bo + 4 * HTB, b2, voffB); PG8_STAGE8(bo + 5 * HTB, b2 + hstepB, voffB); PG8_STAGE8(bo, a2, voffA);
            PG8_WAIT_V(8); PG8_WAIT_L(0); PG8_BAR; PG8_MMA(1, 0, At, B0); PG8_MMA(1, 1, At, B1); PG8_BAR; PG8_SCHED;
#undef PG8_RLD
        }
        } else
        for (int t = 0; t < nt; t += 2) {
            const bool last = (t == nt - 2);
            const char* a1 = cA + (size_t)(t + 1) * kstep;
            const char* a2 = last ? nA : cA + (size_t)(t + 2) * kstep; const char* b2 = last ? nB : cB + (size_t)(t + 2) * kstep;
            const char* a3 = a2 + kstep; const char* b3 = b2 + kstep;
            PG8_LDB(B0, 0, 0); PG8_LDB(B1, 0, 1); PG8_SCHED; PG8_LDA(At, 0, 0); PG8_STAGE(PG8_SA(1, 1), a1 + hstepA, voffA);
            PG8_WAIT_V(8); PG8_WAIT_L(0); PG8_BAR; PG8_MMA(0, 0, At, B0); PG8_MMA(0, 1, At, B1); PG8_BAR; PG8_SCHED;
            PG8_LDA(At, 0, 1); PG8_STAGE(PG8_SB(0, 0), b2, voffB); PG8_STAGE(PG8_SB(0, 1), b2 + hstepB, voffB); PG8_STAGE(PG8_SA(0, 0), a2, voffA);
            PG8_WAIT_V(8); PG8_WAIT_L(0); PG8_BAR; PG8_MMA(1, 0, At, B0); PG8_MMA(1, 1, At, B1); PG8_BAR; PG8_SCHED;
            PG8_LDB(B0, 1, 0); PG8_LDB(B1, 1, 1); PG8_SCHED; PG8_LDA(At, 1, 0); PG8_STAGE(PG8_SA(0, 1), a2 + hstepA, voffA);
            PG8_WAIT_V(8); PG8_WAIT_L(0); PG8_BAR; PG8_MMA(0, 0, At, B0); PG8_MMA(0, 1, At, B1); PG8_BAR; PG8_SCHED;
            PG8_LDA(At, 1, 1); PG8_STAGE(PG8_SB(1, 0), b3, voffB); PG8_STAGE(PG8_SB(1, 1), b3 + hstepB, voffB); PG8_STAGE(PG8_SA(1, 0), a3, voffA);
            PG8_WAIT_V(8); PG8_WAIT_L(0); PG8_BAR; PG8_MMA(1, 0, At, B0); PG8_MMA(1, 1, At, B1); PG8_BAR; PG8_SCHED;
        }
        if (wr == 0) PG8_BAR;
        bool keep = false;
        int tz = tid; asm volatile("" : "+v"(tz));
        const int fr2 = tz & 15, fq2 = (tz & 63) >> 4;
        if constexpr (Epi::CONT) { keep = (cur.kind == 0); if (keep) E.mid(acc, cur, wr, wc, fr2, fq2); else E(acc, cur, wr, wc, fr2, fq2); }
        else E(acc, cur, wr, wc, fr2, fq2);
        if (!has_next) break;
        if (!keep) {
#pragma unroll
        for (int a = 0; a < 2; ++a)
#pragma unroll
            for (int b = 0; b < 2; ++b)
#pragma unroll
                for (int m = 0; m < 4; ++m)
#pragma unroll
                    for (int n = 0; n < 2; ++n) acc[a][b][m][n] = (f32x4){0.f, 0.f, 0.f, 0.f};
        }
        cur = nxt; cA = nA; cB = nB; ++ui;
        if (wr == 1) PG8_BAR;
    }
    PG8_WAIT_V(0);
    PG8_BAR;
#undef PG8_SA
#undef PG8_SB
#undef PG8_STAGE
#undef PG8_STAGE8
#undef PG8_LDA
#undef PG8_LDB
#undef PG8_MMA
#undef PG8_WAIT_V
#undef PG8_WAIT_L
#undef PG8_BAR
#undef PG8_SCHED
}
template <bool F8, class Epi, class Sched>
__device__ __forceinline__ void gemm_phase(LAS unsigned char* lds, const int K, const int lda, const int ldb, const Sched& S, const Epi& E) {
    f32x4 acc[2][2][4][2];
    gemm_phase_acc<F8>(lds, K, lda, ldb, S, E, acc, true);
}
}
using pg8::Unit;

struct Params {
    const float *x, *mem; const int* pos;
    const float *norm_mix_g, *w_in, *a_norm_g, *a_sw, *a_sb, *p_a, *p_b, *w_out, *norm_x_g, *norm_mem_g, *xq, *xk, *xv, *xo, *norm_ffn_g, *w1, *w3, *w2, *final_g;
    float* out; unsigned char* ws;
    int ph_lo, ph_hi;
};
struct Frame {
    LAS unsigned char* lds;
    int tid, lane, wave, G, bid;
    unsigned char* ws;
};
#define F_PROJ ((bf16_t*)(F.ws + WS_PROJ))
#define F_VT ((bf16_t*)(F.ws + WS_VT))
#define F_Y ((bf16_t*)(F.ws + WS_Y))
#define F_MRG ((bf16_t*)(F.ws + WS_MRG))
#define F_SSQV ((float*)(F.ws + CT_SSQV))
#define F_SSQ1 ((float*)(F.ws + CT_SSQ1))
#define F_SSQ2 ((float*)(F.ws + CT_SSQ2))
#define F_SSQ3 ((float*)(F.ws + CT_SSQ3))
#define F_RSTDX ((float*)(F.ws + WS_RSTDX))
#define F_RSTDM ((float*)(F.ws + WS_RSTDM))
#define F_ROPEB ((float*)(F.ws + WS_ROPEB))
#define F_ROPEI ((float*)(F.ws + WS_ROPEI))
#define F_MASK ((unsigned*)(F.ws + WS_MASK))

#define EPI_ROW(ai, m) (u.pm * 256 + (ai) * 128 + wr * 64 + (m) * 16 + fr)
#define EPI_COL(bj) (u.pn * 256 + (bj) * 128 + wc * 32 + 8 * fq)
#define EPI_LOAD8(v, ai, bj, m, s) do { const f32x4 _a = acc[ai][bj][m][0], _b = acc[ai][bj][m][1]; v[0] = _a[0] * (s); v[1] = _a[1] * (s); v[2] = _a[2] * (s); v[3] = _a[3] * (s); v[4] = _b[0] * (s); v[5] = _b[1] * (s); v[6] = _b[2] * (s); v[7] = _b[3] * (s); } while (0)

template <int PART>
struct EpiProj {
    static constexpr bool CONT = false;
    bf16_t* proj; bf16_t* vT; bf16_t* vTa; const float* rstd_x; float* ssq_v; const float* rope_b; const float* rope_i; bf16_t* kx; bf16_t* vxT; const float* rstd_m; float asc;
    __device__ __forceinline__ void operator()(const f32x4 (&acc)[2][2][4][2], const Unit& u, int wr, int wc, int fr, int fq) const {
        if constexpr (PART == 2) {
        if (u.kind == 1) {
#pragma unroll
            for (int ai = 0; ai < 2; ++ai)
#pragma unroll
                for (int m = 0; m < 4; ++m) { const int row = EPI_ROW(ai, m); const float rs = rstd_m[row];
#pragma unroll
                    for (int bj = 0; bj < 2; ++bj) { float v[8]; EPI_LOAD8(v, ai, bj, m, rs); *(u32x4*)(kx + (size_t)row * 1024 + EPI_COL(bj)) = pack8(v); } }
            return;
        }
        if (u.kind == 2) {
#pragma unroll
            for (int bj = 0; bj < 2; ++bj) { const int c0 = EPI_COL(bj); const f32x4 s0 = *(const f32x4*)(rstd_m + c0), s1 = *(const f32x4*)(rstd_m + c0 + 4);
#pragma unroll
                for (int ai = 0; ai < 2; ++ai)
#pragma unroll
                    for (int m = 0; m < 4; ++m) { const int row = EPI_ROW(ai, m); float v[8]; EPI_LOAD8(v, ai, bj, m, 1.f);
                        v[0] *= s0[0]; v[1] *= s0[1]; v[2] *= s0[2]; v[3] *= s0[3]; v[4] *= s1[0]; v[5] *= s1[1]; v[6] *= s1[2]; v[7] *= s1[3];
                        *(u32x4*)(vxT + (size_t)row * 1024 + c0) = pack8(v); } }
            return;
        }
        } else {
        const int pn = (PART == 0 && u.pn >= 16) ? u.pn + 12 : u.pn;
        if (PART == 0 && u.pn < 16) {
#pragma unroll
            for (int ai = 0; ai < 2; ++ai)
#pragma unroll
                for (int m = 0; m < 4; ++m) { const int row = EPI_ROW(ai, m); const float rs = rstd_x[row] * asc; float ss = 0.f;
#pragma unroll
                    for (int bj = 0; bj < 2; ++bj) { float v[8]; EPI_LOAD8(v, ai, bj, m, rs);
#pragma unroll
                        for (int j = 0; j < 8; ++j) { v[j] = gelu_tanh(v[j]); ss += v[j] * v[j]; }
                        const u32x4 w = pack8(v);
                        if (pn < 8) *(u32x4*)(proj + (size_t)row * NPROJ + EPI_COL(bj)) = w;
                        else { const int cc = (pn - 8) * 256 + bj * 128 + wc * 32 + 8 * fq; bf16_t* tp = vTa + ((size_t)((row >> 11) * 2048 + cc)) * 2048 + (row & 2047);
                            tp[0] = (bf16_t)(w.x & 0xffffu); tp[2048] = (bf16_t)(w.x >> 16); tp[2 * 2048] = (bf16_t)(w.y & 0xffffu); tp[3 * 2048] = (bf16_t)(w.y >> 16);
                            tp[4 * 2048] = (bf16_t)(w.z & 0xffffu); tp[5 * 2048] = (bf16_t)(w.z >> 16); tp[6 * 2048] = (bf16_t)(w.w & 0xffffu); tp[7 * 2048] = (bf16_t)(w.w >> 16); } }
                    if (pn >= 8) { ss += __shfl_xor(ss, 16); ss += __shfl_xor(ss, 32); if (fq == 0) atomicAdd(ssq_v + row, ss); } }
        } else if (PART == 1 && pn < 26) {
#pragma unroll
            for (int ai = 0; ai < 2; ++ai)
#pragma unroll
                for (int m = 0; m < 4; ++m) { const int row = EPI_ROW(ai, m); const float rs = rstd_x[row] * asc;
                    const f32x4 c0 = *(const f32x4*)(rope_b + (size_t)row * 32 + 8 * (fq & 1)), c1 = *(const f32x4*)(rope_b + (size_t)row * 32 + 8 * (fq & 1) + 4);
                    const f32x4 s0 = *(const f32x4*)(rope_b + (size_t)row * 32 + 16 + 8 * (fq & 1)), s1 = *(const f32x4*)(rope_b + (size_t)row * 32 + 16 + 8 * (fq & 1) + 4);
                    const float cs[8] = {c0[0], c0[1], c0[2], c0[3], c1[0], c1[1], c1[2], c1[3]}, sn[8] = {s0[0], s0[1], s0[2], s0[3], s1[0], s1[1], s1[2], s1[3]};
#pragma unroll
                    for (int bj = 0; bj < 2; ++bj) { float v[8]; EPI_LOAD8(v, ai, bj, m, rs);
                        if (wc == 0) {
#pragma unroll
                            for (int j = 0; j < 8; ++j) { const float o = __shfl_xor(v[j], 32); v[j] = (fq < 2) ? (v[j] * cs[j] - o * sn[j]) : (v[j] * cs[j] + o * sn[j]); } }
                        *(u32x4*)(proj + (size_t)row * NPROJ + EPI_COL(bj)) = pack8(v); } }
        } else if (PART == 1 && pn < 28) {
#pragma unroll
            for (int ai = 0; ai < 2; ++ai)
#pragma unroll
                for (int m = 0; m < 4; ++m) { const int row = EPI_ROW(ai, m); const float rs = rstd_x[row] * asc; const int b = row >> 11, s = row & 2047;
#pragma unroll
                    for (int bj = 0; bj < 2; ++bj) { float v[8]; EPI_LOAD8(v, ai, bj, m, rs); const u32x4 w = pack8(v);
                        *(u32x4*)(proj + (size_t)row * NPROJ + EPI_COL(bj)) = w;
                        const int cc = (pn - 26) * 256 + bj * 128 + wc * 32 + 8 * fq; bf16_t* tp = vT + ((size_t)(b * 512 + cc)) * 2048 + s;
                        tp[0] = (bf16_t)(w.x & 0xffffu); tp[2048] = (bf16_t)(w.x >> 16); tp[2 * 2048] = (bf16_t)(w.y & 0xffffu); tp[3 * 2048] = (bf16_t)(w.y >> 16);
                        tp[4 * 2048] = (bf16_t)(w.z & 0xffffu); tp[5 * 2048] = (bf16_t)(w.z >> 16); tp[6 * 2048] = (bf16_t)(w.w & 0xffffu); tp[7 * 2048] = (bf16_t)(w.w >> 16); } }
        } else if (PART == 0) {
#pragma unroll
            for (int ai = 0; ai < 2; ++ai)
#pragma unroll
                for (int m = 0; m < 4; ++m) { const int row = EPI_ROW(ai, m); const float rs = rstd_x[row] * asc;
                    const f32x4 c0 = *(const f32x4*)(rope_i + (size_t)row * 16), c1 = *(const f32x4*)(rope_i + (size_t)row * 16 + 4), s0 = *(const f32x4*)(rope_i + (size_t)row * 16 + 8), s1 = *(const f32x4*)(rope_i + (size_t)row * 16 + 12);
                    const float cs[8] = {c0[0], c0[1], c0[2], c0[3], c1[0], c1[1], c1[2], c1[3]}, sn[8] = {s0[0], s0[1], s0[2], s0[3], s1[0], s1[1], s1[2], s1[3]};
#pragma unroll
                    for (int bj = 0; bj < 2; ++bj) { float v[8]; EPI_LOAD8(v, ai, bj, m, rs);
                        const bool rot = (pn < 32) ? ((wc & 1) == 0) : (bj == 0 && wc == 0);
                        if (rot) {
#pragma unroll
                            for (int j = 0; j < 8; ++j) { const float o = __shfl_xor(v[j], 16); v[j] = (fq == 0) ? (v[j] * cs[j] - o * sn[j]) : ((fq == 1) ? (v[j] * cs[j] + o * sn[j]) : v[j]); } }
                        *(u32x4*)(proj + (size_t)row * NPROJ + pn * 256 + bj * 128 + wc * 32 + 8 * fq) = pack8(v);   } }
        } else {
            const bool isa = u.pn >= 200; const int gt = isa ? u.pn - 200 : u.pn - 100; bf16_t* gp = proj + (isa ? C_GA : C_GB) + gt * 256;
#pragma unroll
            for (int ai = 0; ai < 2; ++ai)
#pragma unroll
                for (int m = 0; m < 4; ++m) { const int row = EPI_ROW(ai, m); const float rs = rstd_x[row] * asc;
#pragma unroll
                    for (int bj = 0; bj < 2; ++bj) { float v[8]; EPI_LOAD8(v, ai, bj, m, rs);
#pragma unroll
                        for (int j = 0; j < 8; ++j) { const float g = sigmoidf_(v[j]); v[j] = isa ? g : fmaxf(g, 1.0e-20f); }
                        *(u32x4*)(gp + (size_t)row * NPROJ + bj * 128 + wc * 32 + 8 * fq) = pack8(v); } }
        }
        }
    }
};
struct EpiMerge {
    static constexpr bool CONT = true;
    bf16_t* mrg; const bf16_t* proj;
    __device__ __forceinline__ void mid(f32x4 (&acc)[2][2][4][2], const Unit& u, int wr, int wc, int fr, int fq) const {
#pragma unroll
        for (int ai = 0; ai < 2; ++ai) { u32x4 ga[4][2], gb[4][2];
#pragma unroll
            for (int m = 0; m < 4; ++m) { const int row = EPI_ROW(ai, m);
#pragma unroll
                for (int bj = 0; bj < 2; ++bj) { ga[m][bj] = *(const u32x4*)(proj + (size_t)row * NPROJ + C_GA + EPI_COL(bj)); gb[m][bj] = *(const u32x4*)(proj + (size_t)row * NPROJ + C_GB + EPI_COL(bj)); } }
#pragma unroll
            for (int m = 0; m < 4; ++m)
#pragma unroll
                for (int bj = 0; bj < 2; ++bj) { float g[8], h[8]; unpack8(ga[m][bj], g); unpack8(gb[m][bj], h);
#pragma unroll
                    for (int j = 0; j < 8; ++j) g[j] *= F8_SYP * __builtin_amdgcn_rcpf(h[j]);
                    acc[ai][bj][m][0] *= (f32x4){g[0], g[1], g[2], g[3]}; acc[ai][bj][m][1] *= (f32x4){g[4], g[5], g[6], g[7]};
                    asm volatile("" : "+v"(acc[ai][bj][m][0]), "+v"(acc[ai][bj][m][1])); } }
    }
    __device__ __forceinline__ void operator()(const f32x4 (&acc)[2][2][4][2], const Unit& u, int wr, int wc, int fr, int fq) const {
#pragma unroll
        for (int ai = 0; ai < 2; ++ai)
#pragma unroll
            for (int m = 0; m < 4; ++m) { const int row = EPI_ROW(ai, m);
#pragma unroll
                for (int bj = 0; bj < 2; ++bj) { const int c0 = EPI_COL(bj); float v[8], g[8]; EPI_LOAD8(v, ai, bj, m, F8_IYP);
                    unpack8(*(const u32x4*)(proj + (size_t)row * NPROJ + C_GB + c0), g);
#pragma unroll
                    for (int j = 0; j < 8; ++j) v[j] *= g[j];
                    *(u32x4*)(mrg + (size_t)row * DM + c0) = pack8(v); } }
    }
};
template <bool IN_F32>
struct EpiResid {
    static constexpr bool CONT = false;
    const void* xi; bf16_t* xb; float* ssq;
    __device__ __forceinline__ void operator()(const f32x4 (&acc)[2][2][4][2], const Unit& u, int wr, int wc, int fr, int fq) const {
#pragma unroll
        for (int ai = 0; ai < 2; ++ai)
#pragma unroll
            for (int m = 0; m < 4; ++m) { const int row = EPI_ROW(ai, m); float ss = 0.f;
#pragma unroll
                for (int bj = 0; bj < 2; ++bj) { const int c0 = EPI_COL(bj); const size_t off = (size_t)row * DM + c0; float r[8];
                    if (IN_F32) { const f32x4 r0 = *(const f32x4*)((const float*)xi + off), r1 = *(const f32x4*)((const float*)xi + off + 4); r[0] = r0[0]; r[1] = r0[1]; r[2] = r0[2]; r[3] = r0[3]; r[4] = r1[0]; r[5] = r1[1]; r[6] = r1[2]; r[7] = r1[3]; }
                    else unpack8(*(const u32x4*)((const bf16_t*)xi + off), r);
                    const f32x4 a0 = acc[ai][bj][m][0], a1 = acc[ai][bj][m][1];
                    r[0] += a0[0]; r[1] += a0[1]; r[2] += a0[2]; r[3] += a0[3]; r[4] += a1[0]; r[5] += a1[1]; r[6] += a1[2]; r[7] += a1[3];
                    ss += (r[0] * r[0] + r[1] * r[1]) + (r[2] * r[2] + r[3] * r[3]) + (r[4] * r[4] + r[5] * r[5]) + (r[6] * r[6] + r[7] * r[7]);
                    *(u32x4*)(xb + off) = pack8(r); }
                ss += __shfl_xor(ss, 16); ss += __shfl_xor(ss, 32); if (fq == 0) atomicAdd(ssq + row, ss); }
    }
};
struct EpiQx {
    static constexpr bool CONT = false;
    bf16_t* q0; bf16_t* q1; const float* ssq1;
    __device__ __forceinline__ void operator()(const f32x4 (&acc)[2][2][4][2], const Unit& u, int wr, int wc, int fr, int fq) const {
        bf16_t* q = u.kind ? q1 : q0;
#pragma unroll
        for (int ai = 0; ai < 2; ++ai)
#pragma unroll
            for (int m = 0; m < 4; ++m) { const int row = EPI_ROW(ai, m); const float rs = 0.0625f * __builtin_amdgcn_rsqf(ssq1[row] * (1.f / DM) + EPS);
#pragma unroll
                for (int bj = 0; bj < 2; ++bj) { float v[8]; EPI_LOAD8(v, ai, bj, m, rs); *(u32x4*)(q + (size_t)row * 1024 + EPI_COL(bj)) = pack8(v); } }
    }
};
struct EpiFfnUp {
    static constexpr bool CONT = false;
    bf16_t* hdn; const float* ssq2;
    __device__ __forceinline__ void operator()(const f32x4 (&acc)[2][2][4][2], const Unit& u, int wr, int wc, int fr, int fq) const {
#pragma unroll
        for (int ai = 0; ai < 2; ++ai)
#pragma unroll
            for (int m = 0; m < 4; ++m) { const int row = EPI_ROW(ai, m); const float rs = __builtin_amdgcn_rsqf(ssq2[row] * (1.f / DM) + EPS);
                float g[8], w[8]; EPI_LOAD8(g, ai, 0, m, rs); EPI_LOAD8(w, ai, 1, m, rs);
#pragma unroll
                for (int j = 0; j < 8; ++j) g[j] = g[j] * sigmoidf_(g[j]) * w[j];
                *(u32x4*)(hdn + (size_t)row * FFN + u.pn * 128 + wc * 32 + 8 * fq) = pack8(g); }
    }
};

struct SchedZa { int G, c; const char *xb, *win;
    __device__ __forceinline__ bool next(int i, Unit& u) const { const int L = i * G + c; if (L >= 672) return false; const size_t ts = (size_t)256 * DM * 2;
        pg8::tile_of(L, 32, 21, u.pm, u.pn); u.kind = 0; u.A = xb + u.pm * ts; u.B = win + u.pn * ts; return true; } };
struct SchedF8 { int G, c, skip5, extra; const char *xb8, *win8;
    __device__ __forceinline__ bool next(int i, Unit& u) const { int L = i * G + c;
        if (skip5) { if (i >= 5) return false; } else if (extra >= 0 && i == 6) L = 5 * G + extra; else if (L >= 1408) return false;
        const size_t ts = (size_t)256 * DM;
        int pn8; pg8::tile_of(L, 32, 44, u.pm, pn8); u.pn = pn8 < 12 ? 16 + pn8 : (pn8 < 28 ? 200 + (pn8 - 12) : 100 + (pn8 - 28)); u.kind = 0; u.A = xb8 + u.pm * ts; u.B = win8 + pn8 * ts; return true; } };
struct SchedKV { int G, c; const char *memb, *wk, *wv;
    __device__ __forceinline__ bool next(int i, Unit& u) const { const int j = i * G + c; if (j >= 32) return false; const size_t ts = (size_t)256 * DM * 2; const int t = j & 15;
        u.kind = 1 + (j >> 4); u.pm = t >> 2; u.pn = t & 3;
        if (u.kind == 1) { u.A = memb + u.pm * ts; u.B = wk + u.pn * ts; } else { u.A = wv + u.pm * ts; u.B = memb + u.pn * ts; } return true; } };
struct SchedOne { Unit u0;
    __device__ __forceinline__ bool next(int i, Unit& u) const { if (i) return false; u = u0; return true; } };
struct SchedSimple { int G, c, nM, nN; const char *A, *B; size_t tsA, tsB;
    __device__ __forceinline__ bool next(int i, Unit& u) const { const int L = i * G + c; if (L >= nM * nN) return false; pg8::tile_of(L, nM, nN, u.pm, u.pn); u.kind = 0;
        u.A = A + u.pm * tsA; u.B = B + u.pn * tsB; return true; } };
struct SchedG6 { int G, c; const char *x1b, *wq;
    __device__ __forceinline__ bool next(int i, Unit& u) const { const int L = i * G + c; if (L >= 256) return false; pg8::tile_of(L & 127, 32, 4, u.pm, u.pn); u.kind = L >> 7;
        const size_t ts = (size_t)256 * DM * 2; u.A = x1b + u.pm * ts + (u.kind ? 2048 * 2 : 0); u.B = wq + u.pn * ts + (u.kind ? 2048 * 2 : 0); return true; } };

#ifndef CVT_KTB
#define CVT_KTB 128
#endif
#ifndef CVT_KT8
#define CVT_KT8 256
#endif
constexpr int KTB = CVT_KTB, KT8 = CVT_KT8, CVT_SCR = 17408;
template <bool NT_ST, class Src>
__device__ __forceinline__ void cvt_tile(const float* __restrict__ W, int K, int N, const float* __restrict__ gain, bf16_t* __restrict__ WT, LAS unsigned char* scr, int k0, int n0, int lane, Src src) {
    constexpr int PITCH = KTB * 2 + 16, LPR = KTB / 8;
    const int g = lane >> 4, c = lane & 15, sc = src(n0 + 4 * c);
#pragma unroll
    for (int p = 0; p < KTB / 64; ++p) { const int kk = k0 + 64 * p;
        f32x4 v[16];
        if (sc >= 0) { const float* wp = W + (size_t)(kk + 16 * g) * N + sc;
#pragma unroll
            for (int i = 0; i < 16; ++i) v[i] = __builtin_nontemporal_load((const f32x4*)(wp + (size_t)i * N)); }
        else {
#pragma unroll
            for (int i = 0; i < 16; ++i) v[i] = (f32x4){0.f, 0.f, 0.f, 0.f}; }
        if (gain) {
#pragma unroll
            for (int q = 0; q < 4; ++q) { const f32x4 gq = *(const f32x4*)(gain + kk + 16 * g + 4 * q); v[4 * q] *= gq[0]; v[4 * q + 1] *= gq[1]; v[4 * q + 2] *= gq[2]; v[4 * q + 3] *= gq[3]; } }
#pragma unroll
        for (int j = 0; j < 4; ++j) { u32x4 a, b2;
            a.x = pk2(v[0][j], v[1][j]); a.y = pk2(v[2][j], v[3][j]); a.z = pk2(v[4][j], v[5][j]); a.w = pk2(v[6][j], v[7][j]);
            b2.x = pk2(v[8][j], v[9][j]); b2.y = pk2(v[10][j], v[11][j]); b2.z = pk2(v[12][j], v[13][j]); b2.w = pk2(v[14][j], v[15][j]);
            LAS unsigned char* sp = scr + (4 * c + j) * PITCH + 128 * p + 32 * g; *(LAS u32x4*)sp = a; *(LAS u32x4*)(sp + 16) = b2; } }
    LDS_WAIT(); asm volatile("" ::: "memory");
#pragma unroll
    for (int r = 0; r < LPR; ++r) { const int row = (64 / LPR) * r + lane / LPR, ch = lane % LPR; const u32x4 o = *(const LAS u32x4*)(scr + row * PITCH + 16 * ch);
        u32x4* dp = (u32x4*)(WT + (size_t)(n0 + row) * K + k0 + 8 * ch); if (NT_ST) __builtin_nontemporal_store(o, dp); else *dp = o; }
    LDS_WAIT(); asm volatile("" ::: "memory");
}
template <class Src>
__device__ __forceinline__ void cvt_tile8(const float* __restrict__ W, int K, int N, const float* __restrict__ gain, float scale, unsigned char* __restrict__ WT8, LAS unsigned char* scr, int k0, int n0, int n0dst, int lane, Src src) {
    constexpr int PITCH = KT8 + 16, LPR = KT8 / 16;
    const int g = lane >> 4, c = lane & 15, sc = src(n0 + 4 * c);
#pragma unroll
    for (int p = 0; p < KT8 / 64; ++p) { const int kk = k0 + 64 * p;
        f32x4 v[16];
        if (sc >= 0) { const float* wp = W + (size_t)(kk + 16 * g) * N + sc;
#pragma unroll
            for (int i = 0; i < 16; ++i) v[i] = __builtin_nontemporal_load((const f32x4*)(wp + (size_t)i * N)); }
        else {
#pragma unroll
            for (int i = 0; i < 16; ++i) v[i] = (f32x4){0.f, 0.f, 0.f, 0.f}; }
#pragma unroll
        for (int q = 0; q < 4; ++q) { f32x4 gq = gain ? *(const f32x4*)(gain + kk + 16 * g + 4 * q) : (f32x4){1.f, 1.f, 1.f, 1.f}; gq *= scale; v[4 * q] *= gq[0]; v[4 * q + 1] *= gq[1]; v[4 * q + 2] *= gq[2]; v[4 * q + 3] *= gq[3]; }
#pragma unroll
        for (int j = 0; j < 4; ++j) { u32x4 a;
            a.x = pk4_fp8(v[0][j], v[1][j], v[2][j], v[3][j]); a.y = pk4_fp8(v[4][j], v[5][j], v[6][j], v[7][j]); a.z = pk4_fp8(v[8][j], v[9][j], v[10][j], v[11][j]); a.w = pk4_fp8(v[12][j], v[13][j], v[14][j], v[15][j]);
            *(LAS u32x4*)(scr + (4 * c + j) * PITCH + 64 * p + 16 * g) = a; } }
    LDS_WAIT(); asm volatile("" ::: "memory");
#pragma unroll
    for (int r = 0; r < LPR; ++r) { const int row = (64 / LPR) * r + lane / LPR, ch = lane % LPR; const u32x4 o = *(const LAS u32x4*)(scr + row * PITCH + 16 * ch);
        *(u32x4*)(WT8 + (size_t)(n0dst + row) * K + k0 + 16 * ch) = o; }
    LDS_WAIT(); asm volatile("" ::: "memory");
}
struct SrcId { static constexpr bool NTL = true; __device__ __forceinline__ int operator()(int n) const { return n; } };
struct SrcId0 { static constexpr bool NTL = false; __device__ __forceinline__ int operator()(int n) const { return n; } };
struct SrcWinB { static constexpr bool NTL = false; __device__ __forceinline__ int operator()(int n) const { if (n < 4096) return n; if (n < 5200) return 7168 + (n - 4096); return -1; } };
struct SrcWin8 { static constexpr bool NTL = false; __device__ __forceinline__ int operator()(int n) const { return n < 3072 ? 4096 + n : 8272 + (n - 3072); } };
struct Src13 { static constexpr bool NTL = true; __device__ __forceinline__ int operator()(int n) const { return (n >> 8) * 128 + (n & 127); } };
__device__ __forceinline__ void row_to_bf16(const float* xrow, bf16_t* orow, unsigned* o8row, float* rstd, int lane) {
    const f32x4* xr = (const f32x4*)xrow + lane; float s = 0.f; f32x4 v[16];
#pragma unroll
    for (int j = 0; j < 16; ++j) { v[j] = xr[64 * j]; s += (v[j][0] * v[j][0] + v[j][1] * v[j][1]) + (v[j][2] * v[j][2] + v[j][3] * v[j][3]); }
    s = wave_sum(s);
    if (lane == 0) *rstd = 1.0f / sqrtf(s * (1.f / DM) + EPS);
    u32x2* o8 = (u32x2*)orow + lane;
#pragma unroll
    for (int j = 0; j < 16; ++j) { u32x2 w; w.x = pk2(v[j][0], v[j][1]); w.y = pk2(v[j][2], v[j][3]); o8[64 * j] = w; }
    if (o8row) {
#pragma unroll
        for (int j = 0; j < 16; ++j) o8row[64 * j + lane] = pk4_fp8(v[j][0] * F8_SA, v[j][1] * F8_SA, v[j][2] * F8_SA, v[j][3] * F8_SA); }
}
struct CvtItem { const float* wp; const float* gp; unsigned char* dst; int N, K; float scale; int f8, nts; };
constexpr int CW_BUF = 69632, CW_PB = 272, CW_P8 = 144;
template <class Src>
__device__ __forceinline__ void cw_fill(CvtItem& it, const float* W, int K, int N, const float* gain, float scale, unsigned char* dst, int eb, int kb, int nb, int wave, int lane, Src src) {
    const int k0 = kb * 128, n0 = nb * 256, sc = src(n0 + 4 * lane);
    it.wp = sc >= 0 ? W + (size_t)(k0 + 16 * wave) * N + sc : nullptr; it.gp = gain ? gain + k0 + 16 * wave : nullptr; it.dst = dst + ((size_t)n0 * K + k0) * eb; it.N = N; it.K = K; it.scale = scale; it.f8 = (eb == 1); it.nts = Src::NTL;
}
__device__ __forceinline__ void cw_load(const CvtItem& it, f32x4 (&v)[16]) {
    if (it.wp) {
#pragma unroll
        for (int i = 0; i < 16; ++i) v[i] = __builtin_nontemporal_load((const f32x4*)(it.wp + (size_t)i * it.N)); }
    else {
#pragma unroll
        for (int i = 0; i < 16; ++i) v[i] = (f32x4){0.f, 0.f, 0.f, 0.f}; }
}
__device__ __forceinline__ void cw_to_lds(const CvtItem& it, f32x4 (&v)[16], LAS unsigned char* buf, int wave, int lane) {
#pragma unroll
    for (int i = 0; i < 16; ++i) { const float g = (it.gp ? it.gp[i] : 1.f) * it.scale; v[i] *= g; }
    if (it.f8) {
#pragma unroll
        for (int j = 0; j < 4; ++j) { u32x4 a;
            a.x = pk4_fp8(v[0][j], v[1][j], v[2][j], v[3][j]); a.y = pk4_fp8(v[4][j], v[5][j], v[6][j], v[7][j]); a.z = pk4_fp8(v[8][j], v[9][j], v[10][j], v[11][j]); a.w = pk4_fp8(v[12][j], v[13][j], v[14][j], v[15][j]);
            *(LAS u32x4*)(buf + (4 * lane + j) * CW_P8 + 16 * wave) = a; } }
    else {
#pragma unroll
        for (int j = 0; j < 4; ++j) { u32x4 a, b2;
            a.x = pk2(v[0][j], v[1][j]); a.y = pk2(v[2][j], v[3][j]); a.z = pk2(v[4][j], v[5][j]); a.w = pk2(v[6][j], v[7][j]);
            b2.x = pk2(v[8][j], v[9][j]); b2.y = pk2(v[10][j], v[11][j]); b2.z = pk2(v[12][j], v[13][j]); b2.w = pk2(v[14][j], v[15][j]);
            LAS unsigned char* sp = buf + (4 * lane + j) * CW_PB + 32 * wave; *(LAS u32x4*)sp = a; *(LAS u32x4*)(sp + 16) = b2; } }
}
__device__ __forceinline__ void cw_store(const CvtItem& it, LAS unsigned char* buf, int tid) {
    if (it.f8) {
#pragma unroll
        for (int rr = 0; rr < 4; ++rr) { const int row = 64 * rr + (tid >> 3), ch = tid & 7; const u32x4 o = *(const LAS u32x4*)(buf + row * CW_P8 + 16 * ch);
            u32x4* dp = (u32x4*)(it.dst + (size_t)row * it.K + 16 * ch); if (it.nts) __builtin_nontemporal_store(o, dp); else *dp = o; } }
    else {
#pragma unroll
        for (int rr = 0; rr < 8; ++rr) { const int row = 32 * rr + (tid >> 4), ch = tid & 15; const u32x4 o = *(const LAS u32x4*)(buf + row * CW_PB + 16 * ch);
            u32x4* dp = (u32x4*)(it.dst + (size_t)row * it.K * 2 + 16 * ch); if (it.nts) __builtin_nontemporal_store(o, dp); else *dp = o; } }
}
template <class Get>
__device__ __forceinline__ void cw_run(Frame& F, int first, int step, int end, Get get) {
    if (first >= end) return;
    int tz = F.tid; asm volatile("" : "+v"(tz));
    const int wave = F.wave, lane = tz & 63;
    CvtItem c0, c1, st; f32x4 v0[16], v1[16];
    get(first, wave, lane, c0); cw_load(c0, v0); c1 = c0;
    if (first + step < end) { get(first + step, wave, lane, c1); cw_load(c1, v1); }
    __syncthreads();
    for (int r = first; r < end; r += 2 * step) {
        cw_to_lds(c0, v0, F.lds, wave, lane); st = c0;
        if (r + 2 * step < end) { get(r + 2 * step, wave, lane, c0); cw_load(c0, v0); }
        __syncthreads();
        cw_store(st, F.lds, tz);
        if (r + step >= end) break;
        cw_to_lds(c1, v1, F.lds + CW_BUF, wave, lane); st = c1;
        if (r + 3 * step < end) { get(r + 3 * step, wave, lane, c1); cw_load(c1, v1); }
        __syncthreads();
        cw_store(st, F.lds + CW_BUF, tz);
    }
    __syncthreads();
}
constexpr int CW_WINB = 32 * 21, CW_WIN8 = 32 * 44, CW_XQ = 32 * 4, CW_XO = 8 * 16, CW_N0 = CW_WINB + CW_WIN8 + 3 * CW_XQ + CW_XO;
constexpr int CW_WOUT = 32 * 16, CW_PB8 = 16 * 16, CW_PA = 16 * 16, CW_W2 = (FFN / 128) * 16, CW_W13 = 32 * (N13 / 256), CW_NL = CW_WOUT + CW_PB8 + CW_PA + CW_W2 + CW_W13;
__device__ __forceinline__ void cw_item_p0(const Params& P, unsigned char* ws, int r, int wave, int lane, CvtItem& it) {
    if (r < CW_WINB) { cw_fill(it, P.w_in, DM, 16464, P.norm_mix_g, 1.f, ws + WS_WIN, 2, r / 21, r % 21, wave, lane, SrcWinB()); return; } r -= CW_WINB;
    if (r < CW_WIN8) { cw_fill(it, P.w_in, DM, 16464, P.norm_mix_g, F8_SB, ws + WS_WIN8, 1, r / 44, r % 44, wave, lane, SrcWin8()); return; } r -= CW_WIN8;
    if (r < CW_XQ) { cw_fill(it, P.xq, DM, 1024, P.norm_x_g, 1.f, ws + WS_WQ, 2, r / 4, r % 4, wave, lane, SrcId()); return; } r -= CW_XQ;
    if (r < CW_XQ) { cw_fill(it, P.xk, DM, 1024, P.norm_mem_g, 1.f, ws + WS_WK, 2, r / 4, r % 4, wave, lane, SrcId0()); return; } r -= CW_XQ;
    if (r < CW_XQ) { cw_fill(it, P.xv, DM, 1024, P.norm_mem_g, 1.f, ws + WS_WV, 2, r / 4, r % 4, wave, lane, SrcId0()); return; } r -= CW_XQ;
    cw_fill(it, P.xo, 1024, DM, nullptr, 1.f, ws + WS_WO, 2, r / 16, r % 16, wave, lane, SrcId());
}
__device__ __forceinline__ void cw_item_late(const Params& P, unsigned char* ws, int r, int wave, int lane, CvtItem& it) {
    if (r < CW_WOUT) { cw_fill(it, P.w_out, DM, DM, nullptr, 1.f, ws + WS_WOUT, 2, r / 16, r % 16, wave, lane, SrcId()); return; } r -= CW_WOUT;
    if (r < CW_PB8) { cw_fill(it, P.p_b, 2048, DM, nullptr, F8_SPB, ws + WS_PB, 1, r / 16, r % 16, wave, lane, SrcId()); return; } r -= CW_PB8;
    if (r < CW_PA) { cw_fill(it, P.p_a, 2048, DM, nullptr, 1.f, ws + WS_PA, 2, r / 16, r % 16, wave, lane, SrcId()); return; } r -= CW_PA;
    if (r < CW_W2) { cw_fill(it, P.w2, FFN, DM, nullptr, 1.f, ws + WS_W2, 2, r / 16, r % 16, wave, lane, SrcId()); return; } r -= CW_W2;
    { const int nb = r % (N13 / 256); const float* W = (((nb * 256 + 4 * lane) >> 7) & 1) ? P.w3 : P.w1; cw_fill(it, W, DM, FFN, P.norm_ffn_g, 1.f, ws + WS_W13, 2, r / (N13 / 256), nb, wave, lane, Src13()); }
}
#ifndef N_FREE_WG
#define N_FREE_WG 40
#endif
#ifndef P0_MID
#define P0_MID 0
#endif
#ifndef P0_W2_PCT
#define P0_W2_PCT 0
#endif
constexpr int I_WINB = (DM / KTB) * 84, I_WIN8 = (DM / KT8) * 176, I_PB = (2048 / KT8) * 64, I_PA = (2048 / KTB) * 64, I_WOUT = (DM / KTB) * 64, I_XQ = (DM / KTB) * 16, I_XO = (1024 / KTB) * 64, I_2 = (FFN / KTB) * 64, I_13 = (DM / KTB) * (N13 / 64);
constexpr int N_MIDLATE = I_PB + I_PA + I_WOUT + I_2 + I_13;
constexpr int N_MID_EARLY = P0_MID * (I_PB + I_PA + I_WOUT) + (I_2 * P0_W2_PCT) / 100;
__device__ __forceinline__ void midlate_item(const Params& P, unsigned char* ws, LAS unsigned char* scr, int r, int lane) {
    if (r < I_WOUT) { cvt_tile<true>(P.w_out, DM, DM, nullptr, (bf16_t*)(ws + WS_WOUT), scr, KTB * (r / 64), 64 * (r % 64), lane, SrcId()); return; } r -= I_WOUT;
    if (r < I_PB) { cvt_tile8(P.p_b, 2048, DM, nullptr, F8_SPB, ws + WS_PB, scr, KT8 * (r / 64), 64 * (r % 64), 64 * (r % 64), lane, SrcId()); return; } r -= I_PB;
    if (r < I_PA) { cvt_tile<true>(P.p_a, 2048, DM, nullptr, (bf16_t*)(ws + WS_PA), scr, KTB * (r / 64), 64 * (r % 64), lane, SrcId()); return; } r -= I_PA;
    if (r < I_2) { cvt_tile<true>(P.w2, FFN, DM, nullptr, (bf16_t*)(ws + WS_W2), scr, KTB * (r / 64), 64 * (r % 64), lane, SrcId()); return; } r -= I_2;
    { const int nb = N13 / 64, n0 = 64 * (r % nb); cvt_tile<true>(((n0 >> 7) & 1) ? P.w3 : P.w1, DM, FFN, P.norm_ffn_g, (bf16_t*)(ws + WS_W13), scr, KTB * (r / nb), n0, lane, Src13()); }
}
__device__ __forceinline__ void p0_prologue(Frame& F, const Params& P, const bool with_late) {
    LAS unsigned char* scr = F.lds + F.wave * CVT_SCR;
    const int gw = F.bid * 8 + F.wave, NGW = F.G * 8, lane = F.lane;
    unsigned char* ws = F.ws;
    cw_run(F, F.bid, F.G, CW_N0, [&](int r, int wv, int ln, CvtItem& it) { cw_item_p0(P, ws, r, wv, ln, it); });
    if (with_late) cw_run(F, F.bid, F.G, CW_NL, [&](int r, int wv, int ln, CvtItem& it) { cw_item_late(P, ws, r, wv, ln, it); });
    for (int m = gw; m < M; m += NGW) row_to_bf16(P.x + (size_t)m * DM, (bf16_t*)(ws + WS_XB) + (size_t)m * DM, (unsigned*)(ws + WS_XB8) + (size_t)m * (DM / 4), F_RSTDX + m, lane);
    for (int m = gw; m < MEMR; m += NGW) row_to_bf16(P.mem + (size_t)m * DM, (bf16_t*)(ws + WS_MEMB) + (size_t)m * DM, nullptr, F_RSTDM + m, lane);
    const int gt = F.bid * 512 + F.tid, NGT = F.G * 512;
    for (int e = gt; e < M * 24; e += NGT) { const int row = e / 24, i = e % 24; const bool isb = i < 16; const int fi = isb ? i : i - 16;
        const float inv = powf(500000.0f, isb ? -(float)fi / 16.0f : -(float)fi / 8.0f); const float ang = (float)P.pos[row] * inv;
        const double tr = (double)ang * 0.15915494309189535; const float fr = (float)(tr - rint(tr));
        const float cv = __builtin_amdgcn_cosf(fr), sv = __builtin_amdgcn_sinf(fr);
        if (isb) { F_ROPEB[(size_t)row * 32 + fi] = cv; F_ROPEB[(size_t)row * 32 + 16 + fi] = sv; } else { F_ROPEI[(size_t)row * 16 + fi] = cv; F_ROPEI[(size_t)row * 16 + 8 + fi] = sv; } }
    bf16_t* Wc = (bf16_t*)(ws + WS_WC);
    for (int e = gt; e < 16 * 128 * 128; e += NGT) { const int s = e & 127, t = (e >> 7) & 127; Wc[e] = (s <= t) ? (bf16_t)(pk2(P.a_sw[e], 0.f) & 0xffffu) : (bf16_t)0; }
}

__device__ __forceinline__ void convert_late(Frame& F, const Params& P, unsigned* ctr) {
    LAS unsigned char* scr = F.lds + F.wave * CVT_SCR;
    for (;;) {
        unsigned r = 0; if (F.lane == 0) r = atomicAdd(ctr, 1u);
        r = (unsigned)__builtin_amdgcn_readfirstlane((int)r) + (unsigned)N_MID_EARLY;
        if (r >= (unsigned)N_MIDLATE) break;
        midlate_item(P, F.ws, scr, (int)r, F.lane);
    }
}

__device__ __forceinline__ void spatial_unit(Frame& F, const Params& P, int unit) {
    const int g = unit & 15, c = (unit >> 4) & 15, b = unit >> 8, row0 = b * SEQ + c * 128;
    int tz = F.tid; asm volatile("" : "+v"(tz));
    const int wt = F.wave >> 1, wd = F.wave & 1, fr = tz & 15, fq = (tz & 63) >> 4;
    const bf16_t* Wc = (const bf16_t*)(F.ws + WS_WC) + (size_t)g * 128 * 128;
    const bf16_t* vTa = (const bf16_t*)(F.ws + WS_VTA) + ((size_t)(b * 2048 + g * 128 + 64 * wd + fr)) * 2048 + c * 128 + 8 * fq;
    f32x4 acc[2][4];
#pragma unroll
    for (int i = 0; i < 2; ++i)
#pragma unroll
        for (int j = 0; j < 4; ++j) acc[i][j] = (f32x4){0.f, 0.f, 0.f, 0.f};
    u32x2 uw[2][4]; f32x4 gn[4]; float bias[2];
#pragma unroll
    for (int j = 0; j < 4; ++j) gn[j] = *(const f32x4*)(P.a_norm_g + g * 128 + 64 * wd + 16 * j + 4 * fq);
#pragma unroll
    for (int i = 0; i < 2; ++i) { const int t = 32 * wt + 16 * i + fr; bias[i] = P.a_sb[g * 128 + t];
#pragma unroll
        for (int j = 0; j < 4; ++j) uw[i][j] = *(const u32x2*)(F_PROJ + (size_t)(row0 + t) * NPROJ + C_U + g * 128 + 64 * wd + 16 * j + 4 * fq); }
#pragma unroll
    for (int ks = 0; ks < 4; ++ks) {
        if (ks <= wt) {
            const f32x4 q0 = *(const f32x4*)(F_SSQV + row0 + 32 * ks + 8 * fq), q1 = *(const f32x4*)(F_SSQV + row0 + 32 * ks + 8 * fq + 4);
            float rs[8];
#pragma unroll
            for (int e = 0; e < 4; ++e) { rs[e] = __builtin_amdgcn_rsqf(q0[e] * (1.f / 2048.f) + EPS); rs[4 + e] = __builtin_amdgcn_rsqf(q1[e] * (1.f / 2048.f) + EPS); }
            bf16x8 af[2], bg[4];
#pragma unroll
            for (int i = 0; i < 2; ++i) { float wv[8]; unpack8(*(const u32x4*)(Wc + (32 * wt + 16 * i + fr) * 128 + 32 * ks + 8 * fq), wv);
#pragma unroll
                for (int e = 0; e < 8; ++e) wv[e] *= rs[e];
                af[i] = __builtin_bit_cast(bf16x8, pack8(wv)); }
#pragma unroll
            for (int j = 0; j < 4; ++j) bg[j] = *(const bf16x8*)(vTa + (size_t)(16 * j) * 2048 + 32 * ks);
#pragma unroll
            for (int i = 0; i < 2; ++i)
#pragma unroll
                for (int j = 0; j < 4; ++j) acc[i][j] = MFMA16(bg[j], af[i], acc[i][j]);
        }
    }
    bf16_t* Y = F_Y;
#pragma unroll
    for (int i = 0; i < 2; ++i) { const int t = 32 * wt + 16 * i + fr; const float bs = bias[i];
#pragma unroll
        for (int j = 0; j < 4; ++j) { const int d = 64 * wd + 16 * j + 4 * fq; const f32x4 gj = gn[j]; const u32x2 uu = uw[i][j];
            const float y0 = bf_lo(uu.x) * (acc[i][j][0] * gj[0] + bs), y1 = bf_hi(uu.x) * (acc[i][j][1] * gj[1] + bs), y2 = bf_lo(uu.y) * (acc[i][j][2] * gj[2] + bs), y3 = bf_hi(uu.y) * (acc[i][j][3] * gj[3] + bs);
            u32x2 o; o.x = pk2(y0, y1); o.y = pk2(y2, y3); *(u32x2*)(Y + (size_t)(row0 + t) * DM + g * 128 + d) = o; } }
}

__device__ __forceinline__ int wave_isum_dpp(int v) {
    v += __builtin_amdgcn_update_dpp(0, v, 0x111, 0xf, 0xf, true);
    v += __builtin_amdgcn_update_dpp(0, v, 0x112, 0xf, 0xf, true);
    v += __builtin_amdgcn_update_dpp(0, v, 0x114, 0xf, 0xf, true);
    v += __builtin_amdgcn_update_dpp(0, v, 0x118, 0xf, 0xf, true);
    v += __builtin_amdgcn_update_dpp(0, v, 0x142, 0xa, 0xf, false);
    v += __builtin_amdgcn_update_dpp(0, v, 0x143, 0xc, 0xf, false);
    return __builtin_amdgcn_readlane(v, 63);
}
__device__ __forceinline__ void transpose32(unsigned (&a)[32]) {
#pragma unroll
    for (int k = 0; k < 16; ++k) { const unsigned x = a[k], y = a[k + 16]; a[k] = __builtin_amdgcn_perm(y, x, 0x05040100u); a[k + 16] = __builtin_amdgcn_perm(y, x, 0x07060302u); }
#pragma unroll
    for (int k = 0; k < 32; ++k) if (!(k & 8)) { const unsigned x = a[k], y = a[k + 8]; a[k] = __builtin_amdgcn_perm(y, x, 0x06020400u); a[k + 8] = __builtin_amdgcn_perm(y, x, 0x07030501u); }
#pragma unroll
    for (int j = 4; j; j >>= 1) { const unsigned m = j == 4 ? 0x0f0f0f0fu : (j == 2 ? 0x33333333u : 0x55555555u);
#pragma unroll
        for (int k = 0; k < 32; ++k) if (!(k & j)) { const unsigned x = a[k], y = a[k + j]; a[k] = (x & m) | ((y << j) & ~m); a[k + j] = ((x >> j) & m) | (y & ~m); } }
}
__device__ __forceinline__ void sel_planes(const LAS float* sr, int t, int lane, unsigned (&pl)[32]) {
#pragma unroll
    for (int j = 0; j < 32; ++j) { const unsigned bits = __float_as_uint(sr[j]); const unsigned ord = bits ^ ((bits >> 31) ? 0xffffffffu : 0x80000000u); pl[j] = (32 * lane + j <= t) ? ord : 0u; }
    transpose32(pl);
}
__device__ __forceinline__ unsigned sel_finish(unsigned gt, unsigned eq, int need, int ceq, int lane) {
    if (ceq == need) return gt | eq;
    const int myeq = __builtin_popcount(eq); int inc = myeq;
#pragma unroll
    for (int o = 1; o < 64; o <<= 1) { const int v = __shfl_up(inc, o); if (lane >= o) inc += v; }
    int take = need - (inc - myeq); take = take < 0 ? 0 : (take > myeq ? myeq : take);
    unsigned kept = 0u, e = eq; while (take > 0) { const unsigned lo = e & (0u - e); kept |= lo; e ^= lo; --take; }
    return gt | kept;
}
__device__ __forceinline__ void indexer_unit(Frame& F, int b, int tile) {
    int tz = F.tid; asm volatile("" : "+v"(tz));
    const int tok0 = tile * 16, w = F.wave, lane = tz & 63, r = lane & 31, h = lane >> 5;
    LAS float* sc = (LAS float*)F.lds;
    const int tk = tok0 + 2 * w + ((r >> 2) & 1), hd = (r & 3) + 4 * (r >> 3);
    const bf16_t* ap = F_PROJ + (size_t)(b * SEQ + tk) * NPROJ + C_QI + hd * 64 + 8 * h;
    bf16x8 af[4];
#pragma unroll
    for (int s = 0; s < 4; ++s) af[s] = *(const bf16x8*)(ap + 16 * s);
    float wv[16];
    { const bf16_t* wp = F_PROJ + (size_t)(b * SEQ + tok0 + 2 * w + h) * NPROJ + C_WI; float t0[8], t1[8]; unpack8(*(const u32x4*)wp, t0); unpack8(*(const u32x4*)(wp + 8), t1);
#pragma unroll
      for (int j = 0; j < 8; ++j) { wv[j] = t0[j]; wv[8 + j] = t1[j]; } }
    const int nkt = (tok0 + 15) / 32 + 1;
    __syncthreads();
    const bf16_t* kp = F_PROJ + (size_t)(b * SEQ + r) * NPROJ + C_KI + 8 * h;
    bf16x8 kf[4][4];
#pragma unroll
    for (int i = 0; i < 4; ++i) { const bf16_t* kq = kp + (size_t)(i < nkt ? i : nkt - 1) * 32 * NPROJ;
#pragma unroll
        for (int s = 0; s < 4; ++s) kf[i][s] = *(const bf16x8*)(kq + 16 * s); }
    for (int kt = 0; kt < nkt; kt += 4) {
#pragma unroll
        for (int i = 0; i < 4; ++i) {
            if (kt + i < nkt) {
                f32x16 acc;
#pragma unroll
                for (int q = 0; q < 16; ++q) acc[q] = 0.f;
#pragma unroll
                for (int s = 0; s < 4; ++s) acc = MFMA32(af[s], kf[i][s], acc);
                float sco = 0.f;
#pragma unroll
                for (int q = 0; q < 16; ++q) sco += wv[q] * fmaxf(acc[q], 0.f);
                const int key = (kt + i) * 32 + r;
                sc[(2 * w + h) * 2112 + key + (key >> 5)] = sco;
            }
            { const int kn = kt + i + 4; const bf16_t* kq = kp + (size_t)(kn < nkt ? kn : nkt - 1) * 32 * NPROJ;
#pragma unroll
              for (int s = 0; s < 4; ++s) kf[i][s] = *(const bf16x8*)(kq + 16 * s); }
        }
    }
    LDS_WAIT(); asm volatile("" ::: "memory");
    {
        const int tA = tok0 + 2 * w;
        unsigned* mrow = F_MASK + (size_t)(b * SEQ + tA) * 64;
        unsigned wordA, wordB;
        if (tA < 256) {
            const int nA = tA + 1 - 32 * lane, nB = nA + 1;
            wordA = nA >= 32 ? 0xffffffffu : (nA <= 0 ? 0u : ((1u << nA) - 1u)); wordB = nB >= 32 ? 0xffffffffu : (nB <= 0 ? 0u : ((1u << nB) - 1u));
        } else {
            unsigned pa[32], pb[32];
            sel_planes(sc + (2 * w) * 2112 + 33 * lane, tA, lane, pa); sel_planes(sc + (2 * w + 1) * 2112 + 33 * lane, tA + 1, lane, pb);
            unsigned alA = 0xffffffffu, alB = 0xffffffffu, gtA = 0u, gtB = 0u; int abA = 0, abB = 0; bool dA = false, dB = false;
#pragma unroll
            for (int bit = 31; bit >= 0; --bit) {
                if (dA && dB) break;
                const unsigned mA = alA & pa[bit], mB = alB & pb[bit];
                const int tot = wave_isum_dpp(__builtin_popcount(mA) | (__builtin_popcount(mB) << 16));
                const int cA = tot & 0xffff, cB = tot >> 16;
                if (!dA) { if (abA + cA >= 256) { alA = mA; dA = (abA + cA == 256); } else { abA += cA; gtA |= mA; alA &= ~pa[bit]; } }
                if (!dB) { if (abB + cB >= 256) { alB = mB; dB = (abB + cB == 256); } else { abB += cB; gtB |= mB; alB &= ~pb[bit]; } }
            }
            const int tote = wave_isum_dpp(__builtin_popcount(alA) | (__builtin_popcount(alB) << 16));
            wordA = sel_finish(gtA, alA, 256 - abA, tote & 0xffff, lane); wordB = sel_finish(gtB, alB, 256 - abB, tote >> 16, lane);
        }
        mrow[lane] = wordA; mrow[64 + lane] = wordB;
    }
}
__device__ __forceinline__ void attn_unit(Frame& F, int b, int kvh, int qt) {
    constexpr int KP = 272, VP = 144, BUF = 64 * KP + 128 * VP;
    LAS unsigned* mk = (LAS unsigned*)(F.lds + 2 * BUF);
    int tz = F.tid; asm volatile("" : "+v"(tz));
    const int T0 = qt * 64, w = F.wave, lane = tz & 63, q = lane & 31, h = lane >> 5, tg = w >> 2, hq = kvh * 4 + (w & 3);
    const size_t rowq = (size_t)(b * SEQ + T0 + 32 * tg + q);
    bf16x8 qf[8];
    { const bf16_t* qp = F_PROJ + rowq * NPROJ + C_Q + hq * 128 + 8 * h;
#pragma unroll
      for (int ds = 0; ds < 8; ++ds) qf[ds] = *(const bf16x8*)(qp + 16 * ds); }
    const bf16_t* kg = F_PROJ + (size_t)(b * SEQ + (tz >> 4)) * NPROJ + C_K + kvh * 128 + (tz & 15) * 8;
    const bf16_t* vg = F_VT + (size_t)(b * 512 + kvh * 128 + (tz >> 3)) * 2048 + (tz & 7) * 8;
    const int kl = (tz >> 4) * KP + (tz & 15) * 16, vl = 64 * KP + (tz >> 3) * VP + ((tz & 7) >> 1) * 32 + (tz & 1) * 8;
    u32x4 pk0, pk1, pv0, pv1;
    pk0 = *(const u32x4*)kg; pk1 = *(const u32x4*)(kg + (size_t)32 * NPROJ); pv0 = *(const u32x4*)vg; pv1 = *(const u32x4*)(vg + (size_t)64 * 2048);
    __syncthreads();
    for (int i = tz; i < 64 * 64; i += 512) { const int rr = i >> 6, cc = i & 63; mk[rr * 65 + cc] = F_MASK[(size_t)(b * SEQ + T0 + rr) * 64 + cc]; }
    *(LAS u32x4*)(F.lds + kl) = pk0; *(LAS u32x4*)(F.lds + kl + 32 * KP) = pk1; *(LAS u32x2*)(F.lds + vl) = (u32x2){pv0.x, pv0.y}; *(LAS u32x2*)(F.lds + vl + 16) = (u32x2){pv0.z, pv0.w}; *(LAS u32x2*)(F.lds + vl + 64 * VP) = (u32x2){pv1.x, pv1.y}; *(LAS u32x2*)(F.lds + vl + 64 * VP + 16) = (u32x2){pv1.z, pv1.w};
    __syncthreads();
    f32x16 o[4];
#pragma unroll
    for (int dt = 0; dt < 4; ++dt)
#pragma unroll
        for (int i = 0; i < 16; ++i) o[dt][i] = 0.f;
    const float NEG = -1.0e30f, cl = 0.08838834764831845f * 1.4426950408889634f;
    float mrun = NEG, lrun = 0.f;
    const int nkt = qt + 1;
    for (int kt = 0; kt < nkt; ++kt) {
        LAS unsigned char* ldsK = F.lds + (kt & 1) * BUF; LAS unsigned char* ldsV = ldsK + 64 * KP;
        const bool more = kt + 1 < nkt;
        if (more) { const bf16_t* kn = kg + (size_t)(kt + 1) * 64 * NPROJ; const bf16_t* vn = vg + (kt + 1) * 64;
            pk0 = *(const u32x4*)kn; pk1 = *(const u32x4*)(kn + (size_t)32 * NPROJ); pv0 = *(const u32x4*)vn; pv1 = *(const u32x4*)(vn + (size_t)64 * 2048); }
#pragma unroll
        for (int hf = 0; hf < 2; ++hf) {
            f32x16 sv;
#pragma unroll
            for (int i = 0; i < 16; ++i) sv[i] = 0.f;
#pragma unroll
            for (int ds = 0; ds < 8; ++ds) { const bf16x8 kf = *(const LAS bf16x8*)(ldsK + (q + 32 * hf) * KP + (16 * ds + 8 * h) * 2); sv = MFMA32(kf, qf[ds], sv); }
            const unsigned wm = mk[(32 * tg + q) * 65 + 2 * kt + hf] >> (4 * h);
            float tmax = NEG;
#pragma unroll
            for (int i = 0; i < 16; ++i) { const int pos = (i & 3) + 8 * (i >> 2); const int sel = __builtin_amdgcn_sbfe((int)wm, pos, 1); sv[i] = __int_as_float((sel & __float_as_int(sv[i])) | (~sel & __float_as_int(NEG))); tmax = fmaxf(tmax, sv[i]); }
            tmax = xmax32(tmax);
            if (!__all((tmax - mrun) * cl <= 8.0f)) {
                const float mnew = fmaxf(mrun, tmax), alpha = __builtin_amdgcn_exp2f((mrun - mnew) * cl); mrun = mnew; lrun *= alpha;
#pragma unroll
                for (int dt = 0; dt < 4; ++dt)
#pragma unroll
                    for (int i = 0; i < 16; ++i) o[dt][i] *= alpha; }
            const float mc = mrun * cl;
            float ps = 0.f;
#pragma unroll
            for (int i = 0; i < 16; ++i) { sv[i] = __builtin_amdgcn_exp2f(sv[i] * cl - mc); ps += sv[i]; }
            lrun += ps;
            bf16x8 pf[2];
#pragma unroll
            for (int s2 = 0; s2 < 2; ++s2) { u32x4 a; a.x = pk2(sv[8 * s2], sv[8 * s2 + 1]); a.y = pk2(sv[8 * s2 + 2], sv[8 * s2 + 3]); a.z = pk2(sv[8 * s2 + 4], sv[8 * s2 + 5]); a.w = pk2(sv[8 * s2 + 6], sv[8 * s2 + 7]); pf[s2] = __builtin_bit_cast(bf16x8, a); }
#pragma unroll
            for (int dt = 0; dt < 4; ++dt)
#pragma unroll
                for (int s2 = 0; s2 < 2; ++s2) { const u32x4 v4 = *(const LAS u32x4*)(ldsV + (32 * dt + q) * VP + (2 * hf + s2) * 32 + 16 * h);
                    o[dt] = MFMA32(__builtin_bit_cast(bf16x8, v4), pf[s2], o[dt]); }
        }
        if (more) { const int nb = ((kt + 1) & 1) * BUF;
            *(LAS u32x4*)(F.lds + nb + kl) = pk0; *(LAS u32x4*)(F.lds + nb + kl + 32 * KP) = pk1; *(LAS u32x2*)(F.lds + nb + vl) = (u32x2){pv0.x, pv0.y}; *(LAS u32x2*)(F.lds + nb + vl + 16) = (u32x2){pv0.z, pv0.w}; *(LAS u32x2*)(F.lds + nb + vl + 64 * VP) = (u32x2){pv1.x, pv1.y}; *(LAS u32x2*)(F.lds + nb + vl + 64 * VP + 16) = (u32x2){pv1.z, pv1.w}; }
        __syncthreads();
    }
    float inv = 1.0f / xsum32(lrun);
    unsigned char* yp = F.ws + WS_Y8 + rowq * 2048 + hq * 128;
    inv *= F8_SY;
#pragma unroll
    for (int dt = 0; dt < 4; ++dt) { unsigned w4[4];
#pragma unroll
        for (int gq = 0; gq < 4; ++gq) w4[gq] = pk4_fp8(o[dt][4 * gq] * inv, o[dt][4 * gq + 1] * inv, o[dt][4 * gq + 2] * inv, o[dt][4 * gq + 3] * inv);
        const auto r02 = __builtin_amdgcn_permlane32_swap(w4[0], w4[2], false, false); const auto r13 = __builtin_amdgcn_permlane32_swap(w4[1], w4[3], false, false);
        *(u32x4*)(yp + 32 * dt + 16 * h) = (u32x4){r02[0], r02[1], r13[0], r13[1]}; }
}

__device__ __forceinline__ void xattn_unit(Frame& F, int unit) {
    constexpr int KP = 528, VP = 144;
    const int tile = unit & 15, hx = (unit >> 4) & 3, b = unit >> 6;
    int tz = F.tid; asm volatile("" : "+v"(tz));
    const int w = F.wave, lane = tz & 63, fr = lane & 15, fq = lane >> 4;
    const size_t rowq = (size_t)(b * SEQ + tile * 128 + 16 * w + fr);
    const bf16_t* kx = (const bf16_t*)(F.ws + WS_KX); const bf16_t* vxT = (const bf16_t*)(F.ws + WS_VXT);
    bf16x8 qf[8];
    { const bf16_t* q0 = (const bf16_t*)(F.ws + WS_QX0) + rowq * 1024 + hx * 256 + 8 * fq; const bf16_t* q1 = (const bf16_t*)(F.ws + WS_QX1) + rowq * 1024 + hx * 256 + 8 * fq;
#pragma unroll
      for (int ds = 0; ds < 8; ++ds) { float a[8], c[8]; unpack8(*(const u32x4*)(q0 + 32 * ds), a); unpack8(*(const u32x4*)(q1 + 32 * ds), c);
#pragma unroll
          for (int j = 0; j < 8; ++j) a[j] += c[j];
          qf[ds] = __builtin_bit_cast(bf16x8, pack8(a)); } }
    f32x4 ot[16];
#pragma unroll
    for (int i = 0; i < 16; ++i) ot[i] = (f32x4){0.f, 0.f, 0.f, 0.f};
    float mrun = -1.0e30f, l = 0.f;
    LAS unsigned char* ldsK = F.lds; LAS unsigned char* ldsV = F.lds + 64 * KP;
    const bf16_t* kgp = kx + (size_t)(b * 256 + (tz >> 5)) * 1024 + hx * 256 + (tz & 31) * 8;
    const bf16_t* vgp = vxT + (size_t)(hx * 256 + (tz >> 3)) * 1024 + b * 256 + (tz & 7) * 8;
    const int klo = (tz >> 5) * KP + (tz & 31) * 16, vlo = 64 * KP + (tz >> 3) * VP + (tz & 7) * 16;
    u32x4 kr[4], vr[4];
#pragma unroll
    for (int k = 0; k < 4; ++k) { kr[k] = *(const u32x4*)(kgp + (size_t)(16 * k) * 1024); vr[k] = *(const u32x4*)(vgp + (size_t)(64 * k) * 1024); }
#pragma unroll 1
    for (int ch = 0; ch < 4; ++ch) {
        __syncthreads();
#pragma unroll
        for (int k = 0; k < 4; ++k) { *(LAS u32x4*)(F.lds + klo + 16 * k * KP) = kr[k]; *(LAS u32x4*)(F.lds + vlo + 64 * k * VP) = vr[k]; }
        if (ch < 3) {
#pragma unroll
            for (int k = 0; k < 4; ++k) { kr[k] = *(const u32x4*)(kgp + (size_t)((ch + 1) * 64 + 16 * k) * 1024); vr[k] = *(const u32x4*)(vgp + (size_t)(64 * k) * 1024 + (ch + 1) * 64); } }
        __syncthreads();
        f32x4 st[4];
#pragma unroll
        for (int k4 = 0; k4 < 4; ++k4) { st[k4] = (f32x4){0.f, 0.f, 0.f, 0.f};
#pragma unroll
            for (int ds = 0; ds < 8; ++ds) { const bf16x8 kf = *(const LAS bf16x8*)(ldsK + (16 * k4 + fr) * KP + (32 * ds + 8 * fq) * 2); st[k4] = MFMA16(kf, qf[ds], st[k4]); } }
        float mx = -1.0e30f;
#pragma unroll
        for (int i = 0; i < 4; ++i) mx = fmaxf(mx, fmaxf(fmaxf(st[i][0], st[i][1]), fmaxf(st[i][2], st[i][3])));
        mx = fmaxf(mx, shx(mx, lane, 16)); mx = fmaxf(mx, shx(mx, lane, 32));
        const float mnew = fmaxf(mrun, mx), alpha = __builtin_amdgcn_exp2f((mrun - mnew) * 1.4426950408889634f), mc = mnew * 1.4426950408889634f; mrun = mnew;
        float ps = 0.f;
#pragma unroll
        for (int i = 0; i < 4; ++i)
#pragma unroll
            for (int e = 0; e < 4; ++e) { st[i][e] = __builtin_amdgcn_exp2f(st[i][e] * 1.4426950408889634f - mc); ps += st[i][e]; }
        l = l * alpha + ps;
#pragma unroll
        for (int i = 0; i < 16; ++i) ot[i] *= alpha;
        bf16x8 pf[2];
#pragma unroll
        for (int k2 = 0; k2 < 2; ++k2) { u32x4 a; a.x = pk2(st[2 * k2][0], st[2 * k2][1]); a.y = pk2(st[2 * k2][2], st[2 * k2][3]); a.z = pk2(st[2 * k2 + 1][0], st[2 * k2 + 1][1]); a.w = pk2(st[2 * k2 + 1][2], st[2 * k2 + 1][3]); pf[k2] = __builtin_bit_cast(bf16x8, a); }
#pragma unroll
        for (int k2 = 0; k2 < 2; ++k2)
#pragma unroll
            for (int dt = 0; dt < 16; ++dt) { const LAS unsigned char* vp = ldsV + (16 * dt + fr) * VP + (32 * k2 + 4 * fq) * 2;
                const u32x2 a = *(const LAS u32x2*)vp, c = *(const LAS u32x2*)(vp + 32); u32x4 v4; v4.x = a.x; v4.y = a.y; v4.z = c.x; v4.w = c.y;
                ot[dt] = MFMA16(__builtin_bit_cast(bf16x8, v4), pf[k2], ot[dt]); }
    }
    l += shx(l, lane, 16); l += shx(l, lane, 32);
    const float inv = 1.0f / l;
    bf16_t* op = (bf16_t*)(F.ws + WS_OX) + rowq * 1024 + hx * 256 + 4 * fq;
#pragma unroll
    for (int dt = 0; dt < 16; ++dt) { u32x2 ow; ow.x = pk2(ot[dt][0] * inv, ot[dt][1] * inv); ow.y = pk2(ot[dt][2] * inv, ot[dt][3] * inv); *(u32x2*)(op + 16 * dt) = ow; }
}

__global__ void __launch_bounds__(512, 2) hybrid_fwd(Params P) {
    extern __shared__ __attribute__((aligned(16))) unsigned char lds_raw[];
    Frame F;
    F.lds = (LAS unsigned char*)lds_raw; F.tid = threadIdx.x; F.lane = F.tid & 63; F.wave = __builtin_amdgcn_readfirstlane(F.tid >> 6); F.G = gridDim.x; F.bid = blockIdx.x;
    F.ws = P.ws;
    volatile LAS unsigned* MISC = (volatile LAS unsigned*)(F.lds + LDSCTL_OFF);
    for (int u = F.tid; u < (LDS_BYTES - LDSCTL_OFF) / 4; u += 512) MISC[u] = 0u;
    __syncthreads();
    XcdBarrier bar; bar.bar = (unsigned*)(P.ws + WS_CTL) + CW_BAR; bar.x = 0; bar.st = nullptr;
    if (MK_N_LAUNCHES == 1) bar = xcd_barrier_post((unsigned*)(P.ws + WS_CTL) + CW_BAR, MISC + 8);
    const int lo = P.ph_lo, hi = P.ph_hi;
#define IN(k) ((((PH_MASK) >> (k)) & 1) && lo <= (k) && (k) < hi)
#define SEAM(k) do { if (IN(k) && IN((k) + 1)) xcd_barrier(bar); } while (0)
    const int G = F.G, c = F.bid;
    unsigned char* ws = P.ws;

    const int NFREE = (G >= 240) ? N_FREE_WG : 0, Gg = G - NFREE;
    if (IN(0)) { p0_prologue(F, P, NFREE == 0); if (DUP_PHASE == 0) { xcd_barrier(bar); p0_prologue(F, P, NFREE == 0); } } SEAM(0);

    if (IN(1)) {
        EpiProj<0> E0{F_PROJ, F_VT, (bf16_t*)(ws + WS_VTA), F_RSTDX, F_SSQV, F_ROPEB, F_ROPEI, (bf16_t*)(ws + WS_KX), (bf16_t*)(ws + WS_VXT), F_RSTDM, 1.0f};
        EpiProj<1> E8{F_PROJ, F_VT, (bf16_t*)(ws + WS_VTA), F_RSTDX, F_SSQV, F_ROPEB, F_ROPEI, (bf16_t*)(ws + WS_KX), (bf16_t*)(ws + WS_VXT), F_RSTDM, F8_INV};
        EpiProj<2> EK{F_PROJ, F_VT, (bf16_t*)(ws + WS_VTA), F_RSTDX, F_SSQV, F_ROPEB, F_ROPEI, (bf16_t*)(ws + WS_KX), (bf16_t*)(ws + WS_VXT), F_RSTDM, 1.0f};
        SchedKV SK{NFREE ? NFREE : G, NFREE ? c - Gg : c, (const char*)(ws + WS_MEMB), (const char*)(ws + WS_WK), (const char*)(ws + WS_WV)};
        if (c >= Gg) {
            pg8::gemm_phase<false>(F.lds, DM, DM, DM, SK, EK);
            convert_late(F, P, (unsigned*)(ws + CT_CVT));
        } else {
            const int rot = (1408 % Gg) & ~7;
            SchedZa SZ{Gg, c, (const char*)(ws + WS_XB), (const char*)(ws + WS_WIN)};
            pg8::gemm_phase<false>(F.lds, DM, DM, DM, SZ, E0);
            const int nb4 = 672 % Gg, e8 = 1408 % Gg; const bool bal = (Gg == 216);
            const int skip5 = bal && c < nb4, extra = (bal && c >= nb4 && c < 2 * nb4) ? (c - nb4 + rot) % Gg : -1;
            SchedF8 S8{Gg, (c + rot) % Gg, skip5, extra, (const char*)(ws + WS_XB8), (const char*)(ws + WS_WIN8)};
            pg8::gemm_phase<true>(F.lds, DM, DM, DM, S8, E8);
            if (!NFREE) pg8::gemm_phase<false>(F.lds, DM, DM, DM, SK, EK);
        }
    } SEAM(1);

    if (IN(2)) {
        for (int u = c; u < 256; u += G) { const int b = u >> 6, j = u & 63; indexer_unit(F, b, j); indexer_unit(F, b, 127 - j); }
        for (int u = c; u < 1024; u += G) spatial_unit(F, P, u);
        if (DUP_PHASE == 2) { xcd_barrier(bar);
            for (int u = c; u < 256; u += G) { const int b = u >> 6, j = u & 63; indexer_unit(F, b, j); indexer_unit(F, b, 127 - j); }
            for (int u = c; u < 1024; u += G) spatial_unit(F, P, u); }
    } SEAM(2);

    if (IN(3)) {
        for (int u = c; u < 256; u += G) { const int j = u & 15, kvh = (u >> 4) & 3, b = u >> 6; attn_unit(F, b, kvh, 31 - j); attn_unit(F, b, kvh, j); }
        if (DUP_PHASE == 3) { xcd_barrier(bar); for (int u = c; u < 256; u += G) { const int j = u & 15, kvh = (u >> 4) & 3, b = u >> 6; attn_unit(F, b, kvh, 31 - j); attn_unit(F, b, kvh, j); } }
    } SEAM(3);

    if (IN(4)) {
        EpiMerge E{F_MRG, F_PROJ};
        f32x4 acc4[2][2][4][2];
#define P4_TILE(L) do { if ((L) < 512) { Unit u; pg8::tile_of((L), 32, 16, u.pm, u.pn); \
            u.kind = 0; u.A = (const char*)F_Y + (size_t)u.pm * 256 * DM * 2; u.B = (const char*)(ws + WS_PA) + (size_t)u.pn * 256 * 2048 * 2; \
            { SchedOne S{u}; pg8::gemm_phase_acc<false>(F.lds, 2048, DM, 2048, S, E, acc4, true); }       \
            u.kind = 1; u.A = (const char*)(ws + WS_Y8) + (size_t)u.pm * 256 * 2048; u.B = (const char*)(ws + WS_PB) + (size_t)u.pn * 256 * 2048; \
            { SchedOne S{u}; pg8::gemm_phase_acc<true>(F.lds, 2048, 2048, 2048, S, E, acc4, false); } } } while (0)
        P4_TILE(c); P4_TILE(c + G);
        if (c + 2 * G < 512) __builtin_trap();
#undef P4_TILE
    } SEAM(4);

    if (IN(5)) {
        SchedSimple S{G, c, 32, 16, (const char*)F_MRG, (const char*)(ws + WS_WOUT), (size_t)256 * DM * 2, (size_t)256 * DM * 2};
        EpiResid<true> E{P.x, (bf16_t*)(ws + WS_X1B), F_SSQ1};
        pg8::gemm_phase<false>(F.lds, DM, DM, DM, S, E);
    } SEAM(5);

    if (IN(6)) {
        SchedG6 S{G, c, (const char*)(ws + WS_X1B), (const char*)(ws + WS_WQ)};
        EpiQx E{(bf16_t*)(ws + WS_QX0), (bf16_t*)(ws + WS_QX1), F_SSQ1};
        pg8::gemm_phase<false>(F.lds, 2048, DM, DM, S, E);
        if (DUP_PHASE == 6) { xcd_barrier(bar); pg8::gemm_phase<false>(F.lds, 2048, DM, DM, S, E); }
    } SEAM(6);

    if (IN(7)) { for (int u = c; u < 256; u += G) xattn_unit(F, u); if (DUP_PHASE == 7) { xcd_barrier(bar); for (int u = c; u < 256; u += G) xattn_unit(F, u); } } SEAM(7);

    if (IN(8)) {
        SchedSimple S{G, c, 32, 16, (const char*)(ws + WS_OX), (const char*)(ws + WS_WO), (size_t)256 * 1024 * 2, (size_t)256 * 1024 * 2};
        EpiResid<false> E{(const void*)(ws + WS_X1B), (bf16_t*)(ws + WS_X2B), F_SSQ2};
        pg8::gemm_phase<false>(F.lds, 1024, 1024, 1024, S, E);
    } SEAM(8);

    if (IN(9)) {
        SchedSimple S{G, c, 32, 86, (const char*)(ws + WS_X2B), (const char*)(ws + WS_W13), (size_t)256 * DM * 2, (size_t)256 * DM * 2};
        EpiFfnUp E{(bf16_t*)(ws + WS_HDN), F_SSQ2};
        pg8::gemm_phase<false>(F.lds, DM, DM, DM, S, E);
        if (DUP_PHASE == 9) { xcd_barrier(bar); pg8::gemm_phase<false>(F.lds, DM, DM, DM, S, E); }
    } SEAM(9);

    if (IN(10)) {
        SchedSimple S{G, c, 32, 16, (const char*)(ws + WS_HDN), (const char*)(ws + WS_W2), (size_t)256 * FFN * 2, (size_t)256 * FFN * 2};
        EpiResid<false> E{(const void*)(ws + WS_X2B), (bf16_t*)(ws + WS_X3B), F_SSQ3};
        pg8::gemm_phase<false>(F.lds, FFN, FFN, FFN, S, E);
    } SEAM(10);

    if (IN(11)) {
        const int gw = c * 8 + F.wave, NGW = G * 8, lane = F.lane; const bf16_t* x3 = (const bf16_t*)(ws + WS_X3B);
        for (int m = gw; m < M; m += NGW) { const float rs = __builtin_amdgcn_rsqf(F_SSQ3[m] * (1.f / DM) + EPS);
            u32x2 xv[16];
#pragma unroll
            for (int j = 0; j < 16; ++j) xv[j] = *(const u32x2*)(x3 + (size_t)m * DM + 256 * j + 4 * lane);
#pragma unroll
            for (int j = 0; j < 16; ++j) { const int col = 256 * j + 4 * lane; const f32x4 g0 = *(const f32x4*)(P.final_g + col);
                f32x4 o0; o0[0] = bf_lo(xv[j].x) * rs * g0[0]; o0[1] = bf_hi(xv[j].x) * rs * g0[1]; o0[2] = bf_lo(xv[j].y) * rs * g0[2]; o0[3] = bf_hi(xv[j].y) * rs * g0[3];
                __builtin_nontemporal_store(o0, (f32x4*)(P.out + (size_t)m * DM + col)); } }
    }
#undef IN
#undef SEAM
}

extern "C" void kernel_launch(void* const* d_in, const int* in_sizes, int n_in, void* d_out, int out_size, void* d_ws, size_t ws_size, hipStream_t stream) {
    static int grid = 0;
    if (grid == 0) {
        if (n_in != 22 || out_size != M * DM || ws_size < WS_END) { fprintf(stderr, "kernel_launch: unexpected problem (n_in %d, out %d, ws %zu)\n", n_in, out_size, ws_size); grid = -1; return; }
        int dev = 0, cus = 0, per_cu = 0;
        if (hipGetDevice(&dev) != hipSuccess || hipDeviceGetAttribute(&cus, hipDeviceAttributeMultiprocessorCount, dev) != hipSuccess) { grid = -1; return; }
        if (hipFuncSetAttribute((const void*)hybrid_fwd, hipFuncAttributeMaxDynamicSharedMemorySize, LDS_BYTES) != hipSuccess) { fprintf(stderr, "kernel_launch: hipFuncSetAttribute failed\n"); grid = -1; return; }
        if (hipOccupancyMaxActiveBlocksPerMultiprocessor(&per_cu, (const void*)hybrid_fwd, 512, LDS_BYTES) != hipSuccess || per_cu < 1) fprintf(stderr, "kernel_launch: occupancy query reports %d\n", per_cu);
        (void)hipGetLastError();
        grid = cus;
    }
    if (grid < 0) return;
    if (hipMemsetAsync((char*)d_ws + WS_CTL, 0, CTL_ZERO_BYTES, stream) != hipSuccess) return;
    Params p{};
    p.x = (const float*)d_in[0]; p.mem = (const float*)d_in[1]; p.pos = (const int*)d_in[2];
    p.norm_mix_g = (const float*)d_in[3]; p.w_in = (const float*)d_in[4]; p.a_norm_g = (const float*)d_in[5]; p.a_sw = (const float*)d_in[6]; p.a_sb = (const float*)d_in[7];
    p.p_a = (const float*)d_in[8]; p.p_b = (const float*)d_in[9]; p.w_out = (const float*)d_in[10]; p.norm_x_g = (const float*)d_in[11]; p.norm_mem_g = (const float*)d_in[12];
    p.xq = (const float*)d_in[13]; p.xk = (const float*)d_in[14]; p.xv = (const float*)d_in[15]; p.xo = (const float*)d_in[16]; p.norm_ffn_g = (const float*)d_in[17];
    p.w1 = (const float*)d_in[18]; p.w3 = (const float*)d_in[19]; p.w2 = (const float*)d_in[20]; p.final_g = (const float*)d_in[21];
    p.out = (float*)d_out; p.ws = (unsigned char*)d_ws;
    for (int li = 0; li < MK_N_LAUNCHES; ++li) {
        p.ph_lo = (MK_N_LAUNCHES == 1) ? 0 : li; p.ph_hi = (MK_N_LAUNCHES == 1) ? NPHASE : li + 1;
        hipLaunchKernelGGL(hybrid_fwd, dim3(grid), dim3(512), LDS_BYTES, stream, p);
    }
}
```
